# Optimizing an MI355X kernel written in HIP

```python
import math
import jax
import jax.numpy as jnp
from jax import lax
import numpy as np

D_MODEL = 4096
BATCH = 2
SEQ = 8192
DEPTH = 4

GRID_W = 64
CTX_LEN = 256
EPS = 1e-6
NEG_INF = -1e30
ROPE_BASE = 10000.0

N_BRANCHES = 4
BRANCH_WIDTH = D_MODEL // 4
FOURIER_GROUPS = 4
FOURIER_GROUP_DIM = BRANCH_WIDTH // FOURIER_GROUPS
CONV_K = 3
SWA_HEADS = 8
SWA_KV_HEADS = 2
SWA_HEAD_DIM = BRANCH_WIDTH // SWA_HEADS
SWA_WINDOW = 128
SWA_BLOCK = 128
DIFF_HEADS = 8
DIFF_HEAD_DIM = BRANCH_WIDTH // (2 * DIFF_HEADS)
DIFF_BLOCK = 128
GATE_RANK = 256
ADA_RANK = 256
N_MOD = 9
D_FF = 5120
IN_SPLITS = (BRANCH_WIDTH, BRANCH_WIDTH, BRANCH_WIDTH, BRANCH_WIDTH,
             SWA_HEADS * SWA_HEAD_DIM, SWA_KV_HEADS * SWA_HEAD_DIM, SWA_KV_HEADS * SWA_HEAD_DIM,
             2 * DIFF_HEADS * DIFF_HEAD_DIM, 2 * DIFF_HEADS * DIFF_HEAD_DIM, 2 * DIFF_HEADS * DIFF_HEAD_DIM,
             GATE_RANK)
IN_COLS = sum(IN_SPLITS)

kernel_name = 'hybrid_parallel_mixer_dit'


def rms_norm(x, g):
    xf = x.astype(jnp.float32)
    y = xf * lax.rsqrt(jnp.mean(xf * xf, axis=-1, keepdims=True) + EPS)
    return (y * g.astype(jnp.float32)).astype(x.dtype)


def modulate(h, shift, scale):
    return h * (1.0 + scale) + shift


def ada_modulation(cvec, down, up, b):
    m = (jax.nn.silu(cvec) @ down) @ up + b
    return jnp.split(m[..., None, :], N_MOD, axis=-1)


def ffn_half_step(t, shift, scale, gate, g, w13, w2):
    h = modulate(rms_norm(t, g), shift, scale)
    a, u = jnp.split(h @ w13, 2, axis=-1)
    return t + 0.5 * gate * ((jax.nn.silu(a) * u) @ w2)


def axial_rope_tables(row, col, head_dim):
    axis_dim = head_dim // 2
    inv_freq = ROPE_BASE ** (-jnp.arange(0, axis_dim, 2, dtype=jnp.float32) / axis_dim)
    ar = row.astype(jnp.float32)[:, None] * inv_freq
    ac = col.astype(jnp.float32)[:, None] * inv_freq
    return (jnp.cos(ar), jnp.sin(ar), jnp.cos(ac), jnp.sin(ac))


def _rope_rotate(x, cos, sin):
    x1, x2 = jnp.split(x, 2, axis=-1)
    cos = cos[None, :, None, :]
    sin = sin[None, :, None, :]
    return jnp.concatenate([x1 * cos - x2 * sin, x2 * cos + x1 * sin], axis=-1)


def apply_axial_rope(x, rope):
    cr, sr, cc, sc = rope
    xr, xcol = jnp.split(x, 2, axis=-1)
    y = jnp.concatenate([_rope_rotate(xr, cr, sr), _rope_rotate(xcol, cc, sc)], axis=-1)
    return y.astype(x.dtype)


def softmax_with_sink(s, sink):
    m = jnp.maximum(jnp.max(s, axis=-1, keepdims=True), sink)
    e = jnp.exp(s - m)
    return e / (jnp.sum(e, axis=-1, keepdims=True) + jnp.exp(sink - m))


def fourier_mix(u):
    b_, L, _ = u.shape
    ug = u.astype(jnp.float32).reshape(b_, L, FOURIER_GROUPS, FOURIER_GROUP_DIM)
    f = jnp.fft.fft2(ug, axes=(1, 3), norm='ortho').real
    return f.reshape(b_, L, BRANCH_WIDTH).astype(u.dtype)


def short_conv(gb, gc, v, w):
    u = gc * v
    L = u.shape[1]
    up = jnp.pad(u, ((0, 0), (1, 1), (0, 0)))
    y = up[:, 0:L] * w[0] + up[:, 1:L + 1] * w[1] + up[:, 2:L + 2] * w[2]
    return gb * y


def swa_latent(q, k, v, kc, vc, sink):
    b_, S, H, hd = q.shape
    G = H // SWA_KV_HEADS
    nb = S // SWA_BLOCK
    Lc = kc.shape[1]
    qb = q.reshape(b_, nb, SWA_BLOCK, SWA_KV_HEADS, G, hd)

    def windows(t):
        tp = jnp.pad(t, ((0, 0), (SWA_BLOCK, SWA_BLOCK), (0, 0), (0, 0)))
        tp = tp.reshape(b_, nb + 2, SWA_BLOCK, SWA_KV_HEADS, hd)
        return jnp.concatenate([tp[:, :-2], tp[:, 1:-1], tp[:, 2:]], axis=2)

    kw, vw = windows(k), windows(v)
    scale = hd ** -0.5
    s_loc = jnp.einsum('bnqhgd,bnkhd->bnhgqk', qb, kw).astype(jnp.float32) * scale
    s_ctx = jnp.einsum('bnqhgd,bkhd->bnhgqk', qb, kc).astype(jnp.float32) * scale
    blk = jnp.arange(nb)[:, None, None] * SWA_BLOCK
    qpos = blk + jnp.arange(SWA_BLOCK)[None, :, None]
    kpos = blk - SWA_BLOCK + jnp.arange(3 * SWA_BLOCK)[None, None, :]
    valid = (jnp.abs(qpos - kpos) <= SWA_WINDOW) & (kpos >= 0) & (kpos < S)
    s_loc = jnp.where(valid[None, :, None, None], s_loc, NEG_INF)
    sink_b = sink.astype(jnp.float32).reshape(SWA_KV_HEADS, G)[:, :, None, None]
    p = softmax_with_sink(jnp.concatenate([s_ctx, s_loc], axis=-1), sink_b).astype(v.dtype)
    o = (jnp.einsum('bnhgqk,bkhd->bnqhgd', p[..., :Lc], vc)
         + jnp.einsum('bnhgqk,bnkhd->bnqhgd', p[..., Lc:], vw))
    return o.reshape(b_, S, H * hd)


def swa_context(q, k, v, sink):
    b_, L, H, hd = q.shape
    G = H // SWA_KV_HEADS
    qg = q.reshape(b_, L, SWA_KV_HEADS, G, hd)
    s = jnp.einsum('bqhgd,bkhd->bhgqk', qg, k).astype(jnp.float32) * hd ** -0.5
    sink_b = sink.astype(jnp.float32).reshape(SWA_KV_HEADS, G)[:, :, None, None]
    p = softmax_with_sink(s, sink_b).astype(v.dtype)
    return jnp.einsum('bhgqk,bkhd->bqhgd', p, v).reshape(b_, L, H * hd)


def diff_core(q, k, v, lam):
    d = q.shape[-1]
    s = jnp.einsum('bqhcd,bkhcd->bhcqk', q, k).astype(jnp.float32) * d ** -0.5
    p = jax.nn.softmax(s, axis=-1)
    a = p[:, :, 0] - lam * p[:, :, 1]
    return jnp.einsum('bhqk,bkhd->bqhd', a.astype(v.dtype), v)


def diff_latent(q, k, v, kc, vc, lam):
    b_, S, H, _, d = q.shape
    nb = S // DIFF_BLOCK
    k_all = jnp.concatenate([kc, k], axis=1)
    v_all = jnp.concatenate([vc, v], axis=1)
    qb = jnp.moveaxis(q.reshape(b_, nb, DIFF_BLOCK, H, 2, d), 1, 0)
    ob = lax.map(lambda qi: diff_core(qi, k_all, v_all, lam), qb)
    return jnp.moveaxis(ob, 0, 1).reshape(b_, S, H, 2 * d)


def gated_merge(branches, z, w_branch, gate_up, w_out):
    merged = None
    for i, o in enumerate(branches):
        term = jax.nn.sigmoid(z @ gate_up[:, i]) * (o @ w_branch[i])
        merged = term if merged is None else merged + term
    return merged @ w_out


def token_mixers(h_c, h_x, need_ctx_out, rope_swa, rope_diff, lambda_init,
                 w_in, conv_w, swa_q_norm, swa_k_norm, swa_sink,
                 diff_q_norm, diff_k_norm, diff_lambda, diff_subln, w_branch, gate_up, w_out):
    cuts = tuple(int(v) for v in np.cumsum(IN_SPLITS)[:-1])
    pc = jnp.split(h_c @ w_in, cuts, axis=-1)
    px = jnp.split(h_x @ w_in, cuts, axis=-1)

    def heads(t, n, d):
        return t.reshape(t.shape[0], t.shape[1], n, d)

    def swa_q(p, rope):
        q = rms_norm(heads(p[4], SWA_HEADS, SWA_HEAD_DIM), swa_q_norm)
        return q if rope is None else apply_axial_rope(q, rope)

    def swa_kv(p, rope):
        k = rms_norm(heads(p[5], SWA_KV_HEADS, SWA_HEAD_DIM), swa_k_norm)
        k = k if rope is None else apply_axial_rope(k, rope)
        return k, heads(p[6], SWA_KV_HEADS, SWA_HEAD_DIM)

    def diff_qk(t, g, rope):
        b_, L = t.shape[0], t.shape[1]
        u = rms_norm(t.reshape(b_, L, 2 * DIFF_HEADS, DIFF_HEAD_DIM), g)
        if rope is not None:
            u = apply_axial_rope(u, rope)
        return u.reshape(b_, L, DIFF_HEADS, 2, DIFF_HEAD_DIM)

    def diff_v(p):
        return heads(p[9], DIFF_HEADS, 2 * DIFF_HEAD_DIM)

    def diff_out(o):
        o = rms_norm(o, diff_subln) * (1.0 - lambda_init)
        return o.reshape(o.shape[0], o.shape[1], BRANCH_WIDTH)

    dl = diff_lambda.astype(jnp.float32)
    lam = jnp.exp(jnp.sum(dl[0] * dl[1])) - jnp.exp(jnp.sum(dl[2] * dl[3])) + lambda_init

    ks_c, vs_c = swa_kv(pc, None)
    kd_c, vd_c = diff_qk(pc[8], diff_k_norm, None), diff_v(pc)

    ks_x, vs_x = swa_kv(px, rope_swa)
    out_x = gated_merge([
        fourier_mix(px[0]),
        short_conv(px[1], px[2], px[3], conv_w),
        swa_latent(swa_q(px, rope_swa), ks_x, vs_x, ks_c, vs_c, swa_sink),
        diff_out(diff_latent(diff_qk(px[7], diff_q_norm, rope_diff),
                             diff_qk(px[8], diff_k_norm, rope_diff),
                             diff_v(px), kd_c, vd_c, lam)),
    ], px[10], w_branch, gate_up, w_out)
    if not need_ctx_out:
        return out_x, None
    out_c = gated_merge([
        fourier_mix(pc[0]),
        short_conv(pc[1], pc[2], pc[3], conv_w),
        swa_context(swa_q(pc, None), ks_c, vs_c, swa_sink),
        diff_out(diff_core(diff_qk(pc[7], diff_q_norm, None), kd_c, vd_c, lam)),
    ], pc[10], w_branch, gate_up, w_out)
    return out_x, out_c


def setup_inputs(seed: int = 0) -> dict:
    key = jax.random.key(seed)
    ks = jax.random.split(key, 22)
    D = D_MODEL

    def nrm(k, shape, scale):
        return jax.random.normal(k, shape, jnp.float32) * scale

    return {
        'x': nrm(ks[0], (BATCH, SEQ, D), 1.0),
        'c': nrm(ks[1], (BATCH, D), 1.0),
        'ctx': nrm(ks[2], (BATCH, CTX_LEN, D), 1.0),
        'c_ctx': nrm(ks[3], (D,), 1.0),
        'norm_g': 1.0 + nrm(ks[4], (DEPTH, 3, D), 0.02),
        'ada_down': nrm(ks[5], (DEPTH, D, ADA_RANK), D ** -0.5),
        'ada_up': nrm(ks[6], (DEPTH, ADA_RANK, N_MOD * D), 0.5 * ADA_RANK ** -0.5),
        'ada_b': nrm(ks[7], (DEPTH, N_MOD * D), 0.02),
        'ffn_w13': nrm(ks[8], (DEPTH, 2, D, 2 * D_FF), D ** -0.5),
        'ffn_w2': nrm(ks[9], (DEPTH, 2, D_FF, D), D_FF ** -0.5),
        'w_in': nrm(ks[10], (DEPTH, D, IN_COLS), D ** -0.5),
        'conv_w': nrm(ks[11], (DEPTH, CONV_K, BRANCH_WIDTH), CONV_K ** -0.5),
        'swa_q_norm': 1.0 + nrm(ks[12], (DEPTH, SWA_HEAD_DIM), 0.02),
        'swa_k_norm': 1.0 + nrm(ks[13], (DEPTH, SWA_HEAD_DIM), 0.02),
        'swa_sink': nrm(ks[14], (DEPTH, SWA_HEADS), 0.5),
        'diff_q_norm': 1.0 + nrm(ks[15], (DEPTH, DIFF_HEAD_DIM), 0.02),
        'diff_k_norm': 1.0 + nrm(ks[16], (DEPTH, DIFF_HEAD_DIM), 0.02),
        'diff_lambda': nrm(ks[17], (DEPTH, 4, DIFF_HEAD_DIM), 0.1),
        'diff_subln': 1.0 + nrm(ks[18], (DEPTH, 2 * DIFF_HEAD_DIM), 0.02),
        'w_branch': nrm(ks[19], (DEPTH, N_BRANCHES, BRANCH_WIDTH, D), BRANCH_WIDTH ** -0.5),
        'gate_up': nrm(ks[20], (DEPTH, GATE_RANK, N_BRANCHES, D), GATE_RANK ** -0.5),
        'w_out': nrm(ks[21], (DEPTH, D, D), D ** -0.5),
    }


def reference(x, c, ctx, c_ctx, norm_g, ada_down, ada_up, ada_b, ffn_w13, ffn_w2,
              w_in, conv_w, swa_q_norm, swa_k_norm, swa_sink, diff_q_norm, diff_k_norm,
              diff_lambda, diff_subln, w_branch, gate_up, w_out):
    n_lat = x.shape[1]
    rows = n_lat // GRID_W
    row = jnp.repeat(jnp.arange(rows, dtype=jnp.int32), GRID_W)
    col = jnp.tile(jnp.arange(GRID_W, dtype=jnp.int32), rows)
    rope_swa = axial_rope_tables(row, col, SWA_HEAD_DIM)
    rope_diff = axial_rope_tables(row, col, DIFF_HEAD_DIM)

    xc = ctx
    for l in range(DEPTH):
        last = l == DEPTH - 1
        mx = ada_modulation(c, ada_down[l], ada_up[l], ada_b[l])
        mc = ada_modulation(c_ctx, ada_down[l], ada_up[l], ada_b[l])
        x = ffn_half_step(x, mx[0], mx[1], mx[2], norm_g[l, 0], ffn_w13[l, 0], ffn_w2[l, 0])
        xc = ffn_half_step(xc, mc[0], mc[1], mc[2], norm_g[l, 0], ffn_w13[l, 0], ffn_w2[l, 0])
        hx = modulate(rms_norm(x, norm_g[l, 1]), mx[3], mx[4])
        hc = modulate(rms_norm(xc, norm_g[l, 1]), mc[3], mc[4])
        lambda_init = 0.8 - 0.6 * math.exp(-0.3 * l)
        out_x, out_c = token_mixers(hc, hx, not last, rope_swa, rope_diff, lambda_init,
                                    w_in[l], conv_w[l], swa_q_norm[l], swa_k_norm[l], swa_sink[l],
                                    diff_q_norm[l], diff_k_norm[l], diff_lambda[l], diff_subln[l],
                                    w_branch[l], gate_up[l], w_out[l])
        x = x + mx[5] * out_x
        if not last:
            xc = xc + mc[5] * out_c
            xc = ffn_half_step(xc, mc[6], mc[7], mc[8], norm_g[l, 2], ffn_w13[l, 1], ffn_w2[l, 1])
        x = ffn_half_step(x, mx[6], mx[7], mx[8], norm_g[l, 2], ffn_w13[l, 1], ffn_w2[l, 1])
    return x
```

```cpp
#include <hip/hip_runtime.h>
#include <cstdio>
#include <cstdint>

#ifndef MK_PER_PHASE
#define MK_PER_PHASE 1
#endif

#define LAS __attribute__((address_space(3)))
#define GAS __attribute__((address_space(1)))
typedef unsigned short bf16_t;
typedef short bf16x8 __attribute__((ext_vector_type(8)));
typedef short s16x4 __attribute__((ext_vector_type(4)));
typedef float f32x2 __attribute__((ext_vector_type(2)));
typedef float f32x4 __attribute__((ext_vector_type(4)));
typedef float f32x16 __attribute__((ext_vector_type(16)));
typedef unsigned u32x2 __attribute__((ext_vector_type(2)));
typedef unsigned u32x4 __attribute__((ext_vector_type(4)));

constexpr int DM = 4096, NBATCH = 2, SEQ = 8192, DEPTH = 4, CTXL = 256, TB = CTXL + SEQ, T = NBATCH * TB, DFF = 5120, NIN = 8960, NMOD = 9;
constexpr int PANB = TB / 256;
constexpr int C_FOUR = 0, C_CONVB = 1024, C_CONVC = 2048, C_CONVV = 3072, C_SQ = 4096, C_SK = 5120, C_SV = 5376, C_DQ = 5632, C_DK = 6656, C_DV = 7680, C_Z = 8704;
constexpr float EPS = 1e-6f;
constexpr int NWAVES = 8, NTHREADS = 512;

constexpr size_t MiB = 1u << 20;
constexpr size_t WS_CTL = 0, CTL_ZERO_BYTES = 64 * 1024;
constexpr size_t WS_ROPE = 1 * MiB;
constexpr size_t WS_LAM = 1 * MiB + 512 * 1024;
constexpr size_t WS_T1P = 2 * MiB;
constexpr size_t WS_MOD = 3 * MiB;
constexpr size_t WS_CSCT = 5 * MiB;
constexpr size_t WS_CSCTX = 5 * MiB + 512 * 1024;
constexpr size_t WS_CS = 6 * MiB;
constexpr size_t WS_W = 262 * MiB;
constexpr size_t WL_W13 = 0, WL_W2 = 160 * MiB, WL_WIN = 240 * MiB, WL_WB = 310 * MiB, WL_GATE = 342 * MiB, WL_WO = 350 * MiB, WL_SIZE = 382 * MiB;
constexpr size_t WS_XS = WS_W + DEPTH * WL_SIZE;
constexpr size_t WS_H = WS_XS + 264 * MiB;
constexpr size_t WS_ACT = WS_H + 132 * MiB;
constexpr size_t WS_PIECES = WS_ACT + 165 * MiB;
constexpr size_t WS_QS = WS_PIECES + 289 * MiB;
constexpr size_t WS_KS = WS_QS + 33 * MiB;
constexpr size_t WS_QD = WS_KS + 9 * MiB;
constexpr size_t WS_KD = WS_QD + 33 * MiB;
constexpr size_t WS_ABT = WS_KD + 33 * MiB;
constexpr size_t WS_ABTC = WS_ABT + 64 * MiB;
constexpr size_t WS_OB = WS_ABTC + 2 * MiB;
constexpr size_t WS_SIG = WS_OB + 132 * MiB;
constexpr size_t WS_PART = WS_SIG + 528 * MiB;
constexpr size_t WS_MG = WS_PART + 264 * MiB;
constexpr size_t WS_O1 = WS_MG + 132 * MiB;
constexpr size_t WS_END = WS_O1 + 66 * MiB;
constexpr int CW_BAR = 4096;

constexpr int LDS_BYTES = 147456;
constexpr int MISC_OFF = 144 * 1024 - 256;
constexpr int PTR_OFF = MISC_OFF - 256;

#define RLX_AGENT __ATOMIC_RELAXED, __HIP_MEMORY_SCOPE_AGENT
#define LDS_WAIT() asm volatile("s_waitcnt lgkmcnt(0)" ::: "memory")
#define VM_WAIT() asm volatile("s_waitcnt vmcnt(0)" ::: "memory")
typedef __bf16 bf16x2_t __attribute__((ext_vector_type(2)));
__device__ __forceinline__ unsigned cvt_pk_bf16(float lo, float hi) { const f32x2 v = {lo, hi}; const bf16x2_t b = __builtin_convertvector(v, bf16x2_t); return __builtin_bit_cast(unsigned, b); }
__device__ __forceinline__ float bf_lo(unsigned w) { return __uint_as_float(w << 16); }
__device__ __forceinline__ float bf_hi(unsigned w) { return __uint_as_float(w & 0xffff0000u); }
__device__ __forceinline__ float fast_rcp(float x) { return __builtin_amdgcn_rcpf(x); }
__device__ __forceinline__ float sigmoidf_(float x) { return fast_rcp(1.f + __builtin_amdgcn_exp2f(-1.4426950408889634f * x)); }

namespace pg8 {
constexpr int BM = 256, BK = 64, HALF = 128, HTB = HALF * BK * 2, STAGE_BYTES = 8 * HTB, NXCD = 8, WGM = 8;
__host__ __device__ __forceinline__ int lds_byte(int r, int c) { const int st = (r >> 4) * 2 + (c >> 5), rr = r & 15, cc = c & 31, ob = rr * 64 + cc * 2; return st * 1024 + (ob ^ (((ob >> 9) & 1) << 5)); }
__host__ __device__ __forceinline__ void stage_rc(int b, int& R, int& C) { const int st = b / 1024, sb = b % 1024, swz = sb ^ (((sb >> 9) & 1) << 5); R = (st >> 1) * 16 + swz / 64; C = (st & 1) * 32 + (swz % 64) / 2; }
__host__ __device__ __forceinline__ int perm32(int rho) { const int n = rho >> 4, i = rho & 15; return 8 * (i >> 2) + 4 * n + (i & 3); }

struct Unit { int pm, pn, pz; };
struct Gemm { const bf16_t* A; const bf16_t* Bt; int K, lda, ldb; long bsA, bsB; };

struct Order {
    int nM, nN, nZ, nwg, G, c, rep;
    __device__ __forceinline__ void init(int nM_, int nN_, int nZ_, int G_, int c_, int rep_) { nM = nM_; nN = nN_; nZ = nZ_; nwg = nM * nN; G = G_; c = c_; rep = rep_; }
    __device__ __forceinline__ bool next(int i, Unit& u) const {
        long L; int pz;
        if (rep == 1) { L = (long)i * G + c; if (L >= (long)nwg * nZ) return false; pz = (int)(L / nwg); L = L % nwg; }
        else { L = (long)(i / rep) * G + c; if (L >= nwg) return false; pz = i % rep; }
        int wgid = (int)L; { const int q = nwg / NXCD, r = nwg % NXCD, xcd = wgid % NXCD, off = wgid / NXCD; wgid = (xcd < r ? xcd * (q + 1) : r * (q + 1) + (xcd - r) * q) + off; }
        const int nig = WGM * nN, gid = wgid / nig, fm = gid * WGM, gsz = (nM - fm) < WGM ? (nM - fm) : WGM;
        u.pm = fm + ((wgid % nig) % gsz); u.pn = (wgid % nig) / gsz; u.pz = pz; return true;
    }
};

typedef f32x4 Acc[2][2][4][2];

template <class Epi, bool ALIGN_EPI, bool SP2>
__device__ __forceinline__ void gemm_phase(LAS unsigned char* lds, const Gemm g, const Order S, const Epi E) {
    int tid_ = threadIdx.x; asm volatile("" : "+v"(tid_));
    const int tid = tid_, wid = __builtin_amdgcn_readfirstlane(tid >> 6), lane = tid & 63, wr = wid >> 2, wc = wid & 3, fr = lane & 15, fq = lane >> 4;
    const int K = g.K, nt = K / BK;
    unsigned voffA[2], voffB[2];
#pragma unroll
    for (int i = 0; i < 2; ++i) { int R, C; stage_rc(tid * 16 + i * 8192, R, C); const int Rb = Epi::PERM ? ((R & ~31) + perm32(R & 31)) : R;
        voffA[i] = (unsigned)(R * g.lda + C) * 2u; voffB[i] = (unsigned)(Rb * g.ldb + C) * 2u; }
    const size_t kstep = (size_t)(BK * 2);
    const size_t hstepA = (size_t)HALF * g.lda * 2, hstepB = (size_t)HALF * g.ldb * 2;
    const size_t tstepA = 2 * hstepA, tstepB = 2 * hstepB;
    const unsigned ldsw = (unsigned)wid * 1024u;
    const int aoff = lds_byte(wr * 64 + fr, fq * 8), boff = lds_byte(wc * 32 + fr, fq * 8);
#define PG8_SA(b, h) (((b) * 2 + (h)) * HTB)
#define PG8_SB(b, h) ((4 + (b) * 2 + (h)) * HTB)
#define PG8_STAGE(bufoff, gbase, voff) do { _Pragma("unroll") for (int _i = 0; _i < 2; ++_i) \
        __builtin_amdgcn_global_load_lds((const unsigned*)((const char*)(gbase) + (voff)[_i]), (LAS unsigned*)(lds + (bufoff) + ldsw + _i * 8192), 16, 0, 0); } while (0)
#define PG8_LDA(dst, b, h) do { _Pragma("unroll") for (int m = 0; m < 4; ++m) _Pragma("unroll") for (int k = 0; k < 2; ++k) dst[m][k] = *(const LAS bf16x8*)(lds + PG8_SA(b, h) + aoff + m * 2048 + k * 1024); } while (0)
#define PG8_LDB(dst, b, h) do { _Pragma("unroll") for (int n = 0; n < 2; ++n) _Pragma("unroll") for (int k = 0; k < 2; ++k) dst[n][k] = *(const LAS bf16x8*)(lds + PG8_SB(b, h) + boff + n * 2048 + k * 1024); } while (0)
#define PG8_MMA(ai, bj, At, Bt) do { __builtin_amdgcn_s_setprio(1); _Pragma("unroll") for (int m = 0; m < 4; ++m) _Pragma("unroll") for (int n = 0; n < 2; ++n) _Pragma("unroll") for (int k = 0; k < 2; ++k) \
        acc[ai][bj][m][n] = __builtin_amdgcn_mfma_f32_16x16x32_bf16(Bt[n][k], At[m][k], acc[ai][bj][m][n], 0, 0, 0); __builtin_amdgcn_s_setprio(0); } while (0)
#define PG8_WAIT_V(n) asm volatile("s_waitcnt vmcnt(" #n ")" ::: "memory")
#define PG8_WAIT_L(n) asm volatile("s_waitcnt lgkmcnt(" #n ")" ::: "memory")
#define PG8_BAR __builtin_amdgcn_s_barrier()
#define PG8_SCHED __builtin_amdgcn_sched_barrier(0)
    Unit cur, nxt; int ui = 0;
    if (!S.next(0, cur)) return;
    Acc acc;
#pragma unroll
    for (int a = 0; a < 2; ++a)
#pragma unroll
        for (int b = 0; b < 2; ++b)
#pragma unroll
            for (int m = 0; m < 4; ++m)
#pragma unroll
                for (int n = 0; n < 2; ++n) acc[a][b][m][n] = (f32x4){0.f, 0.f, 0.f, 0.f};
    bf16x8 At[4][2], B0[2][2], B1[2][2];
    const char* cA = (const char*)g.A + (size_t)cur.pm * tstepA + (size_t)cur.pz * g.bsA * 2; const char* cB = (const char*)g.Bt + (size_t)cur.pn * tstepB + (size_t)cur.pz * g.bsB * 2;
    if constexpr (SP2) {
        PG8_STAGE(PG8_SB(0, 0), cB, voffB); PG8_STAGE(PG8_SB(0, 1), cB + hstepB, voffB); PG8_STAGE(PG8_SA(0, 0), cA, voffA); PG8_STAGE(PG8_SA(0, 1), cA + hstepA, voffA);
        if (wr == 1) PG8_BAR;
        PG8_WAIT_V(2); PG8_BAR;
        PG8_STAGE(PG8_SB(1, 0), cB + kstep, voffB); PG8_STAGE(PG8_SA(1, 0), cA + kstep, voffA); PG8_STAGE(PG8_SB(1, 1), cB + hstepB + kstep, voffB);
        PG8_WAIT_V(6); PG8_BAR;
    } else {
        PG8_STAGE(PG8_SB(0, 0), cB, voffB); PG8_STAGE(PG8_SA(0, 0), cA, voffA); PG8_STAGE(PG8_SB(0, 1), cB + hstepB, voffB); PG8_STAGE(PG8_SA(0, 1), cA + hstepA, voffA);
        if (wr == 1) PG8_BAR;
        PG8_WAIT_V(4); PG8_BAR;
        PG8_STAGE(PG8_SB(1, 0), cB + kstep, voffB); PG8_STAGE(PG8_SA(1, 0), cA + kstep, voffA); PG8_STAGE(PG8_SB(1, 1), cB + hstepB + kstep, voffB);
        PG8_WAIT_V(6); PG8_BAR;
    }
    for (;;) {
        const bool has_next = S.next(ui + 1, nxt);
        const char* nA = has_next ? (const char*)g.A + (size_t)nxt.pm * tstepA + (size_t)nxt.pz * g.bsA * 2 : cA;
        const char* nB = has_next ? (const char*)g.Bt + (size_t)nxt.pn * tstepB + (size_t)nxt.pz * g.bsB * 2 : cB;
#pragma nounroll
        for (int t = 0; t < nt; t += 2) {
            const bool last = (t == nt - 2);
            const char* a1 = cA + (size_t)(t + 1) * kstep;
            const char* a2 = last ? nA : cA + (size_t)(t + 2) * kstep; const char* b2 = last ? nB : cB + (size_t)(t + 2) * kstep;
            const char* a3 = a2 + kstep; const char* b3 = b2 + kstep;
            if constexpr (SP2) {
            PG8_LDB(B0, 0, 0); PG8_LDB(B1, 0, 1); PG8_SCHED; PG8_LDA(At, 0, 0); PG8_STAGE(PG8_SA(1, 1), a1 + hstepA, voffA);
            PG8_WAIT_V(8); PG8_WAIT_L(0); PG8_BAR; PG8_MMA(0, 0, At, B0); PG8_MMA(0, 1, At, B1); PG8_BAR; PG8_SCHED;
            PG8_LDA(At, 0, 1); PG8_STAGE(PG8_SB(0, 0), b2, voffB); PG8_STAGE(PG8_SB(0, 1), b2 + hstepB, voffB); PG8_STAGE(PG8_SA(0, 0), a2, voffA);
            PG8_WAIT_V(8); PG8_WAIT_L(0); PG8_BAR; PG8_MMA(1, 0, At, B0); PG8_MMA(1, 1, At, B1); PG8_BAR; PG8_SCHED;
            PG8_LDB(B0, 1, 0); PG8_LDB(B1, 1, 1); PG8_SCHED; PG8_LDA(At, 1, 0); PG8_STAGE(PG8_SA(0, 1), a2 + hstepA, voffA);
            PG8_WAIT_V(8); PG8_WAIT_L(0); PG8_BAR; PG8_MMA(0, 0, At, B0); PG8_MMA(0, 1, At, B1); PG8_BAR; PG8_SCHED;
            PG8_LDA(At, 1, 1); PG8_STAGE(PG8_SB(1, 0), b3, voffB); PG8_STAGE(PG8_SB(1, 1), b3 + hstepB, voffB); PG8_STAGE(PG8_SA(1, 0), a3, voffA);
            PG8_WAIT_V(8); PG8_WAIT_L(0); PG8_BAR; PG8_MMA(1, 0, At, B0); PG8_MMA(1, 1, At, B1); PG8_BAR; PG8_SCHED;
            } else {
            PG8_LDB(B0, 0, 0); PG8_SCHED; PG8_LDA(At, 0, 0); PG8_STAGE(PG8_SA(1, 1), a1 + hstepA, voffA);
            PG8_WAIT_L(8); PG8_BAR; PG8_WAIT_L(0); PG8_MMA(0, 0, At, B0); PG8_BAR; PG8_SCHED;
            PG8_LDB(B1, 0, 1); PG8_STAGE(PG8_SB(0, 0), b2, voffB);
            PG8_BAR; PG8_WAIT_L(0); PG8_MMA(0, 1, At, B1); PG8_BAR;
            PG8_LDA(At, 0, 1); PG8_STAGE(PG8_SA(0, 0), a2, voffA);
            PG8_BAR; PG8_WAIT_L(0); PG8_MMA(1, 0, At, B0); PG8_BAR; PG8_SCHED;
            PG8_STAGE(PG8_SB(0, 1), b2 + hstepB, voffB);
            PG8_WAIT_V(6); PG8_BAR; PG8_MMA(1, 1, At, B1); PG8_BAR;
            PG8_LDB(B0, 1, 0); PG8_SCHED; PG8_LDA(At, 1, 0); PG8_STAGE(PG8_SA(0, 1), a2 + hstepA, voffA);
            PG8_WAIT_L(8); PG8_BAR; PG8_WAIT_L(0); PG8_MMA(0, 0, At, B0); PG8_BAR; PG8_SCHED;
            PG8_LDB(B1, 1, 1); PG8_STAGE(PG8_SB(1, 0), b3, voffB);
            PG8_BAR; PG8_WAIT_L(0); PG8_MMA(0, 1, At, B1); PG8_BAR;
            PG8_LDA(At, 1, 1); PG8_STAGE(PG8_SA(1, 0), a3, voffA);
            PG8_BAR; PG8_WAIT_L(0); PG8_MMA(1, 0, At, B0); PG8_BAR; PG8_SCHED;
            PG8_STAGE(PG8_SB(1, 1), b3 + hstepB, voffB);
            PG8_WAIT_V(6); PG8_BAR; PG8_MMA(1, 1, At, B1); PG8_BAR;
            }
        }
        if constexpr (ALIGN_EPI) { if (wr == 0) PG8_BAR; }
        E(acc, cur, wr, wc, fr, fq);
        if (!has_next) break;
#pragma unroll
        for (int a = 0; a < 2; ++a)
#pragma unroll
            for (int b = 0; b < 2; ++b)
#pragma unroll
                for (int m = 0; m < 4; ++m)
#pragma unroll
                    for (int n = 0; n < 2; ++n) acc[a][b][m][n] = (f32x4){0.f, 0.f, 0.f, 0.f};
        cur = nxt; cA = nA; cB = nB; ++ui;
        if constexpr (ALIGN_EPI) { if (wr == 1) PG8_BAR; }
    }
    PG8_WAIT_V(0);
    if constexpr (!ALIGN_EPI) { if (wr == 0) PG8_BAR; }
    PG8_BAR;
#undef PG8_SA
#undef PG8_SB
#undef PG8_STAGE
#undef PG8_LDA
#undef PG8_LDB
#undef PG8_MMA
#undef PG8_WAIT_V
#undef PG8_WAIT_L
#undef PG8_BAR
#undef PG8_SCHED
}

struct EpiBf16 {
    static constexpr bool PERM = true;
    bf16_t* O; int ldc; long rbase, zstride; float scale;
    __device__ __forceinline__ void operator()(const Acc& acc, const Unit& u, int wr, int wc, int fr, int fq) const {
        const long row0 = rbase + (long)u.pz * zstride + u.pm * BM + wr * 64 + fr; const int col0 = u.pn * BM + wc * 32 + 8 * fq;
#pragma unroll
        for (int ai = 0; ai < 2; ++ai)
#pragma unroll
            for (int m = 0; m < 4; ++m) { bf16_t* rowp = O + (size_t)(row0 + ai * HALF + m * 16) * ldc + col0;
#pragma unroll
                for (int bj = 0; bj < 2; ++bj) { const f32x4 v0 = acc[ai][bj][m][0] * scale, v1 = acc[ai][bj][m][1] * scale;
                    u32x4 w; w.x = cvt_pk_bf16(v0[0], v0[1]); w.y = cvt_pk_bf16(v0[2], v0[3]); w.z = cvt_pk_bf16(v1[0], v1[1]); w.w = cvt_pk_bf16(v1[2], v1[3]);
                    *(u32x4*)(rowp + bj * HALF) = w; }
                asm volatile("" ::: "memory"); }
    }
};
struct EpiSwiGLU {
    static constexpr bool PERM = true;
    bf16_t* O; int ldc;
    __device__ __forceinline__ void operator()(const Acc& acc, const Unit& u, int wr, int wc, int fr, int fq) const {
        const int row0 = u.pm * BM + wr * 64 + fr, col0 = u.pn * HALF + wc * 32 + 8 * fq;
#pragma unroll
        for (int ai = 0; ai < 2; ++ai)
#pragma unroll
            for (int m = 0; m < 4; ++m) { bf16_t* rowp = O + (size_t)(row0 + ai * HALF + m * 16) * ldc + col0;
                float v[8];
#pragma unroll
                for (int n = 0; n < 2; ++n)
#pragma unroll
                    for (int j = 0; j < 4; ++j) { const float a = acc[ai][0][m][n][j], g = acc[ai][1][m][n][j]; v[n * 4 + j] = a * sigmoidf_(a) * g; }
                u32x4 w; w.x = cvt_pk_bf16(v[0], v[1]); w.y = cvt_pk_bf16(v[2], v[3]); w.z = cvt_pk_bf16(v[4], v[5]); w.w = cvt_pk_bf16(v[6], v[7]);
                *(u32x4*)rowp = w; asm volatile("" ::: "memory"); }
    }
};
template <bool HALFSTEP>
struct EpiResid {
    static constexpr bool PERM = false;
    float* X; const float* coef; float* dout; int fin;
    __device__ __forceinline__ void operator()(const Acc& acc, const Unit& u, int wr, int wc, int fr, int fq) const {
        constexpr float f = HALFSTEP ? 0.5f : 1.f;
        const int b = u.pm / PANB, ip = u.pm % PANB, v = (ip == 0) ? 2 : b;
        if (!(fin && ip == 0)) {
        const int row0 = u.pm * BM + wr * 64 + fr, col0 = u.pn * BM + wc * 32 + 4 * fq;
        const float* cf = coef + (size_t)v * (NMOD * DM) + col0;
        f32x4 cv[2][2];
#pragma unroll
        for (int bj = 0; bj < 2; ++bj)
#pragma unroll
            for (int n = 0; n < 2; ++n) cv[bj][n] = *(const f32x4*)(cf + bj * HALF + n * 16) * f;
        const float* sbase = X + (size_t)row0 * DM + col0;
        float* dbase = fin ? dout + (size_t)(row0 - CTXL * (b + 1)) * DM + col0 : X + (size_t)row0 * DM + col0;
#pragma unroll
        for (int ai = 0; ai < 2; ++ai)
#pragma unroll
            for (int m = 0; m < 4; ++m) { const size_t ro = (size_t)(ai * HALF + m * 16) * DM;
#pragma unroll
                for (int bj = 0; bj < 2; ++bj)
#pragma unroll
                    for (int n = 0; n < 2; ++n) { const f32x4 x = *(const f32x4*)(sbase + ro + bj * HALF + n * 16); *(f32x4*)(dbase + ro + bj * HALF + n * 16) = x + cv[bj][n] * acc[ai][bj][m][n]; }
                asm volatile("" ::: "memory"); }
        }
    }
};
struct EpiChan {
    static constexpr bool PERM = true;
    bf16_t* ABT; bf16_t* ABTC;
    __device__ __forceinline__ void operator()(const Acc& acc, const Unit& u, int wr, int wc, int fr, int fq) const {
        const int b = u.pn / PANB, ip = u.pn % PANB, g = u.pz, cs = u.pm;
        const int tc = wc * 32 + 8 * fq;
        const bool isc = (ip == 0);
        const unsigned ld = isc ? 512u : 16384u;
        bf16_t* base = isc ? ABTC + ((size_t)(b * 1024 + g * 256)) * 512 + cs * 256 + tc : ABT + ((size_t)(b * 1024 + g * 256)) * 16384 + cs * 8192 + (ip - 1) * 256 + tc;
        base += (size_t)(wr * 64 + fr) * ld;
#pragma unroll
        for (int ai = 0; ai < 2; ++ai)
#pragma unroll
            for (int m = 0; m < 4; ++m) { bf16_t* rowp = base + (size_t)((ai * HALF + m * 16) * ld);
#pragma unroll
                for (int bj = 0; bj < 2; ++bj) { const f32x4 v0 = acc[ai][bj][m][0], v1 = acc[ai][bj][m][1];
                    u32x4 w; w.x = cvt_pk_bf16(v0[0], v0[1]); w.y = cvt_pk_bf16(v0[2], v0[3]); w.z = cvt_pk_bf16(v1[0], v1[1]); w.w = cvt_pk_bf16(v1[2], v1[3]);
                    *(u32x4*)(rowp + bj * HALF) = w; }
                asm volatile("" ::: "memory"); }
    }
};
struct EpiSig {
    static constexpr bool PERM = true;
    bf16_t* O; int ldc;
    __device__ __forceinline__ void operator()(const Acc& acc, const Unit& u, int wr, int wc, int fr, int fq) const {
        const int row0 = u.pm * BM + wr * 64 + fr, col0 = u.pn * BM + wc * 32 + 8 * fq;
#pragma unroll
        for (int ai = 0; ai < 2; ++ai)
#pragma unroll
            for (int m = 0; m < 4; ++m) { bf16_t* rowp = O + (size_t)(row0 + ai * HALF + m * 16) * ldc + col0;
#pragma unroll
                for (int bj = 0; bj < 2; ++bj) { float v[8];
#pragma unroll
                    for (int n = 0; n < 2; ++n)
#pragma unroll
                        for (int j = 0; j < 4; ++j) v[n * 4 + j] = sigmoidf_(acc[ai][bj][m][n][j]);
                    u32x4 w; w.x = cvt_pk_bf16(v[0], v[1]); w.y = cvt_pk_bf16(v[2], v[3]); w.z = cvt_pk_bf16(v[4], v[5]); w.w = cvt_pk_bf16(v[6], v[7]);
                    *(u32x4*)(rowp + bj * HALF) = w; }
                asm volatile("" ::: "memory"); }
    }
};
struct EpiMerge {
    static constexpr bool PERM = false;
    const bf16_t* SIG; float* PART; bf16_t* MG;
    __device__ __forceinline__ void operator()(const Acc& acc, const Unit& u, int wr, int wc, int fr, int fq) const {
        const int row0 = u.pm * BM + wr * 64 + fr, col0 = u.pn * BM + wc * 32 + 4 * fq, i = u.pz;
#pragma unroll
        for (int ai = 0; ai < 2; ++ai)
#pragma unroll
            for (int m = 0; m < 4; ++m) { const size_t row = (size_t)(row0 + ai * HALF + m * 16);
#pragma unroll
                for (int bj = 0; bj < 2; ++bj)
#pragma unroll
                    for (int n = 0; n < 2; ++n) { const int c = col0 + bj * HALF + n * 16;
                        const u32x2 sg = *(const u32x2*)(SIG + row * 16384 + (size_t)i * DM + c);
                        f32x4 s; s[0] = bf_lo(sg.x); s[1] = bf_hi(sg.x); s[2] = bf_lo(sg.y); s[3] = bf_hi(sg.y);
                        f32x4 v = s * acc[ai][bj][m][n];
                        float* pp = PART + row * DM + c;
                        if (i > 0) v = v + *(const f32x4*)pp;
                        if (i < 3) *(f32x4*)pp = v;
                        else { u32x2 w; w.x = cvt_pk_bf16(v[0], v[1]); w.y = cvt_pk_bf16(v[2], v[3]); *(u32x2*)(MG + row * DM + c) = w; } }
                asm volatile("" ::: "memory"); }
    }
};
}

namespace att {
constexpr float THR = 8.f;
#define SBAR() __builtin_amdgcn_sched_barrier(0)
__device__ __forceinline__ int crow(int r, int hi) { return (r & 3) + 8 * (r >> 2) + 4 * hi; }
template <int DQK> __device__ __forceinline__ int kswz(int row, int colB) {
    if (DQK == 128) return row * 256 + (colB ^ ((row & 7) << 4));
    else return row * 128 + (colB ^ (((row >> 1) & 7) << 4));
}
template <int DQK, bool MASKED>
__device__ __forceinline__ void partialSM(f32x16& p0, f32x16& p1, float& m_reg, float& mn, float& alpha, bool domask, int dk, int kp0, int hi) {
    constexpr float SCALE = DQK == 128 ? 0.08838834764831845f : 0.125f;
    constexpr float C = SCALE * 1.4426950408889634f;
    if (MASKED && domask) {
#pragma unroll
        for (int r = 0; r < 16; ++r) { const int kk = crow(r, hi); const int d0 = dk + kk, k0 = kp0 + kk, d1 = d0 + 32, k1 = k0 + 32;
            const bool ok0 = (d0 >= -128) & (d0 <= 128) & (k0 >= 0) & (k0 < SEQ), ok1 = (d1 >= -128) & (d1 <= 128) & (k1 >= 0) & (k1 < SEQ);
            p0[r] = ok0 ? p0[r] : -1e30f; p1[r] = ok1 ? p1[r] : -1e30f; }
    }
    float pmax = p0[0];
#pragma unroll
    for (int r = 1; r < 16; ++r) pmax = fmaxf(pmax, p0[r]);
#pragma unroll
    for (int r = 0; r < 16; ++r) pmax = fmaxf(pmax, p1[r]);
    { auto rr = __builtin_amdgcn_permlane32_swap(__float_as_uint(pmax), __float_as_uint(pmax), false, false);
      pmax = fmaxf(__uint_as_float(rr[0]), __uint_as_float(rr[1])); }
    if (__builtin_expect(__all(pmax - m_reg <= THR / SCALE), 1)) { mn = m_reg; alpha = 1.f; }
    else { mn = fmaxf(m_reg, pmax); alpha = __builtin_amdgcn_exp2f((m_reg - mn) * C); m_reg = mn; }
    const float mnC = -mn * C;
#pragma unroll
    for (int r = 0; r < 16; ++r) p0[r] = fmaf(p0[r], C, mnC);
#pragma unroll
    for (int r = 0; r < 16; ++r) p1[r] = fmaf(p1[r], C, mnC);
#pragma unroll
    for (int r = 0; r < 16; ++r) p0[r] = __builtin_amdgcn_exp2f(p0[r]);
}
__device__ __forceinline__ void finishSM(f32x16& p0, f32x16& p1, float alpha, float& l_reg, bf16x8& pa0, bf16x8& pa1, bf16x8& pa2, bf16x8& pa3) {
#pragma unroll
    for (int r = 0; r < 16; ++r) p1[r] = __builtin_amdgcn_exp2f(p1[r]);
    float ps = 0;
#pragma unroll
    for (int r = 0; r < 16; ++r) ps += p0[r];
#pragma unroll
    for (int r = 0; r < 16; ++r) ps += p1[r];
    { auto rr = __builtin_amdgcn_permlane32_swap(__float_as_uint(ps), __float_as_uint(ps), false, false);
      ps = __uint_as_float(rr[0]) + __uint_as_float(rr[1]); }
    l_reg = l_reg * alpha + ps;
#define PK4(P, BASE, OUT) do { unsigned a0 = cvt_pk_bf16(P[BASE + 0], P[BASE + 1]), a1 = cvt_pk_bf16(P[BASE + 2], P[BASE + 3]);   \
    unsigned b0 = cvt_pk_bf16(P[BASE + 4], P[BASE + 5]), b1 = cvt_pk_bf16(P[BASE + 6], P[BASE + 7]);                              \
    auto r0 = __builtin_amdgcn_permlane32_swap(a0, b0, false, false); auto r1 = __builtin_amdgcn_permlane32_swap(a1, b1, false, false); \
    u32x4 w = {r0[0], r1[0], r0[1], r1[1]}; OUT = *reinterpret_cast<bf16x8*>(&w); } while (0)
    PK4(p0, 0, pa0); PK4(p0, 8, pa1); PK4(p1, 0, pa2); PK4(p1, 8, pa3);
#undef PK4
}
template <int DQK>
__device__ __forceinline__ void qkt(f32x16& p0, f32x16& p1, const LAS char* Ks, const bf16x8* qr, int r32, int hi) {
    p0 = f32x16{}; p1 = f32x16{};
#pragma unroll
    for (int d0 = 0; d0 < DQK / 16; ++d0) { const int cb = (d0 * 16 + hi * 8) * 2;
        const bf16x8 b0 = *reinterpret_cast<const LAS bf16x8*>(Ks + kswz<DQK>(r32, cb));
        const bf16x8 b1 = *reinterpret_cast<const LAS bf16x8*>(Ks + kswz<DQK>(32 + r32, cb));
        p0 = __builtin_amdgcn_mfma_f32_32x32x16_bf16(b0, qr[d0], p0, 0, 0, 0);
        p1 = __builtin_amdgcn_mfma_f32_32x32x16_bf16(b1, qr[d0], p1, 0, 0, 0); }
}
__device__ __forceinline__ int v_st(int k, int c) { const int kk = (k & ~0xC) | ((k & 4) << 1) | ((k & 8) >> 1); return ((kk >> 3) * 4 + (c >> 5)) * 512 + ((kk & 7) * 32 + (c & 31)) * 2; }
__device__ __forceinline__ int v_rd_base(int lane) { return ((lane & 3) << 3) | (((lane >> 2) & 3) << 6) | (((lane >> 4) & 1) << 5) | (((lane >> 5) & 1) << 8); }
constexpr int v_rd_off(int d0, int ks, int half) { return d0 * 512 + ks * 4096 + half * 2048; }
template <int OFF> __device__ __forceinline__ s16x4 tr_read(int vb) {
    s16x4 r; asm volatile("ds_read_b64_tr_b16 %0, %1 offset:%2" : "=&v"(r) : "v"(vb), "i"(OFF) : "memory"); return r;
}
template <int D0> __device__ __forceinline__ void pv_one(f32x16& od, int vb, bf16x8 pa0, bf16x8 pa1, bf16x8 pa2, bf16x8 pa3) {
    const s16x4 l0 = tr_read<v_rd_off(D0, 0, 0)>(vb), h0 = tr_read<v_rd_off(D0, 0, 1)>(vb), l1 = tr_read<v_rd_off(D0, 1, 0)>(vb), h1 = tr_read<v_rd_off(D0, 1, 1)>(vb);
    const s16x4 l2 = tr_read<v_rd_off(D0, 2, 0)>(vb), h2 = tr_read<v_rd_off(D0, 2, 1)>(vb), l3 = tr_read<v_rd_off(D0, 3, 0)>(vb), h3 = tr_read<v_rd_off(D0, 3, 1)>(vb);
    asm volatile("s_waitcnt lgkmcnt(0)" ::: "memory"); SBAR();
#define PK(L, H) (bf16x8){L[0], L[1], L[2], L[3], H[0], H[1], H[2], H[3]}
    od = __builtin_amdgcn_mfma_f32_32x32x16_bf16(pa0, PK(l0, h0), od, 0, 0, 0);
    od = __builtin_amdgcn_mfma_f32_32x32x16_bf16(pa1, PK(l1, h1), od, 0, 0, 0);
    od = __builtin_amdgcn_mfma_f32_32x32x16_bf16(pa2, PK(l2, h2), od, 0, 0, 0);
    od = __builtin_amdgcn_mfma_f32_32x32x16_bf16(pa3, PK(l3, h3), od, 0, 0, 0);
#undef PK
}
__device__ __forceinline__ void pv_d0(f32x16* o, int vb, bf16x8 pa0, bf16x8 pa1, bf16x8 pa2, bf16x8 pa3) {
    pv_one<0>(o[0], vb, pa0, pa1, pa2, pa3); pv_one<1>(o[1], vb, pa0, pa1, pa2, pa3); pv_one<2>(o[2], vb, pa0, pa1, pa2, pa3); pv_one<3>(o[3], vb, pa0, pa1, pa2, pa3);
}

template <int DQK, bool MASKED, int LDQ, int LDK, int LDV>
__device__ __forceinline__ void attn_unit(const bf16_t* __restrict__ Qb, const bf16_t* __restrict__ Kb, const bf16_t* __restrict__ Vb,
                                          int NT, int nctx, int loc0, int qpos0, float m_init, float l_init, LAS char* lds, f32x16 (&o)[4]) {
    constexpr int SHM_V = 64 * 128 * 2, SHM_K = 64 * DQK * 2, NQ = DQK / 16;
    int tid_ = threadIdx.x; asm volatile("" : "+v"(tid_));
    const int tid = tid_, wid = __builtin_amdgcn_readfirstlane(tid >> 6), lane = tid & 63, r32 = lane & 31, hi = lane >> 5;
    LAS char* V_lds = lds; LAS char* K_lds = lds + 2 * SHM_V;
    LAS float* ws = (LAS float*)(lds + 2 * SHM_V + 2 * SHM_K) + wid * 64; LAS float* li_l = ws; LAS float* al_l = ws + 32;
    float m_reg = m_init, l_reg = l_init;
#pragma unroll
    for (int d = 0; d < 4; ++d) o[d] = f32x16{};
    bf16x8 qr[NQ];
    const bf16_t* Qw = Qb + (unsigned)((wid * 32 + r32) * LDQ + hi * 8);
#pragma unroll
    for (int d0 = 0; d0 < NQ; ++d0) qr[d0] = *reinterpret_cast<const bf16x8*>(Qw + d0 * 16);
    const int sr = tid >> 4, sc = (tid & 15) * 8, vst0 = v_st(sr, sc), vst1 = v_st(32 + sr, sc);
    const int kr = (DQK == 128) ? sr : (tid >> 3), kc = (DQK == 128) ? sc : (tid & 7) * 8;
    const int kst0 = kswz<DQK>(kr, kc * 2), kst1 = kswz<DQK>(32 + kr, kc * 2);
    const int vb0 = (int)(unsigned)(uintptr_t)V_lds + v_rd_base(lane);
    const int qrel = qpos0 + wid * 32 + r32;
    const unsigned vo = (unsigned)(sr * LDV + sc) * 2u, ko = (unsigned)(kr * LDK + kc) * 2u;
    struct Slot { bf16x8 vs0, vs1, ks0, ks1; } s0, s1;
#define TROW(j) ((!MASKED || (j) < nctx) ? 64 * (j) : (CTXL + min(max(loc0 + 64 * ((j) - nctx), 0), SEQ - 64)))
#define SLOAD(S, j) do { const int rb_ = TROW(j); const char* vp_ = (const char*)Vb + (size_t)rb_ * (LDV * 2); const char* kp_ = (const char*)Kb + (size_t)rb_ * (LDK * 2); \
    S.vs0 = *reinterpret_cast<const bf16x8*>(vp_ + vo); S.vs1 = *reinterpret_cast<const bf16x8*>(vp_ + 32 * LDV * 2 + vo); \
    S.ks0 = *reinterpret_cast<const bf16x8*>(kp_ + ko); if (DQK == 128) S.ks1 = *reinterpret_cast<const bf16x8*>(kp_ + 32 * LDK * 2 + ko); } while (0)
#define SWRITE(b, S) do { *reinterpret_cast<LAS bf16x8*>(V_lds + (b) * SHM_V + vst0) = S.vs0; *reinterpret_cast<LAS bf16x8*>(V_lds + (b) * SHM_V + vst1) = S.vs1; \
    *reinterpret_cast<LAS bf16x8*>(K_lds + (b) * SHM_K + kst0) = S.ks0; if (DQK == 128) *reinterpret_cast<LAS bf16x8*>(K_lds + (b) * SHM_K + kst1) = S.ks1; } while (0)
#define SWAIT() do { if (DQK == 128) asm volatile("s_waitcnt vmcnt(4)" ::: "memory"); else asm volatile("s_waitcnt vmcnt(3)" ::: "memory"); } while (0)
#define RESC(a) do { if (__any((a) < 1.f)) { if (hi == 0) al_l[r32] = (a); asm volatile("s_waitcnt lgkmcnt(0)" ::: "memory"); \
    _Pragma("unroll") for (int d = 0; d < 4; ++d) _Pragma("unroll") for (int r = 0; r < 16; ++r) o[d][r] *= al_l[crow(r, hi)]; } } while (0)
#define PSM(P0, P1, MN, AL, j) partialSM<DQK, MASKED>(P0, P1, m_reg, MN, AL, MASKED && (j) >= nctx, loc0 + 64 * ((j) - nctx) - qrel, loc0 + 64 * ((j) - nctx), hi)
    f32x16 pA0, pA1, pB0, pB1; float mnA, mnB, alA, alB; bf16x8 pa0, pa1, pa2, pa3;
    SLOAD(s0, 0); asm volatile("s_waitcnt vmcnt(0)" ::: "memory"); SWRITE(0, s0); __syncthreads();
    qkt<DQK>(pA0, pA1, K_lds, qr, r32, hi); PSM(pA0, pA1, mnA, alA, 0);
    SLOAD(s1, 1); if (2 < NT) SLOAD(s0, 2);
    SWAIT(); SWRITE(1, s1); __syncthreads();
    for (int j = 1; j + 1 < NT; j += 2) {
        SBAR(); qkt<DQK>(pB0, pB1, K_lds + SHM_K, qr, r32, hi);
        finishSM(pA0, pA1, alA, l_reg, pa0, pa1, pa2, pa3); SBAR();
        SLOAD(s1, j + 2); SBAR();
        pv_d0(o, vb0, pa0, pa1, pa2, pa3); PSM(pB0, pB1, mnB, alB, j);
        __syncthreads(); SWAIT(); SWRITE(0, s0);
        RESC(alB); __syncthreads();
        SBAR(); qkt<DQK>(pA0, pA1, K_lds, qr, r32, hi);
        finishSM(pB0, pB1, alB, l_reg, pa0, pa1, pa2, pa3); SBAR();
        if (j + 3 < NT) SLOAD(s0, j + 3);
        SBAR();
        pv_d0(o, vb0 + SHM_V, pa0, pa1, pa2, pa3); PSM(pA0, pA1, mnA, alA, j + 1);
        __syncthreads(); SWAIT(); SWRITE(1, s1);
        RESC(alA); __syncthreads();
    }
    SBAR(); qkt<DQK>(pB0, pB1, K_lds + SHM_K, qr, r32, hi);
    finishSM(pA0, pA1, alA, l_reg, pa0, pa1, pa2, pa3); SBAR();
    pv_d0(o, vb0, pa0, pa1, pa2, pa3); PSM(pB0, pB1, mnB, alB, NT - 1);
    __syncthreads(); RESC(alB);
    finishSM(pB0, pB1, alB, l_reg, pa0, pa1, pa2, pa3); SBAR();
    pv_d0(o, vb0 + SHM_V, pa0, pa1, pa2, pa3);
    if (hi == 0) li_l[r32] = l_reg;
    asm volatile("s_waitcnt lgkmcnt(0)" ::: "memory");
#pragma unroll
    for (int r = 0; r < 16; ++r) { const float rl = __builtin_amdgcn_rcpf(li_l[crow(r, hi)]);
#pragma unroll
        for (int d = 0; d < 4; ++d) o[d][r] *= rl; }
    __syncthreads();
#undef TROW
#undef SLOAD
#undef SWRITE
#undef SWAIT
#undef RESC
#undef PSM
}
}

#define XB_TMO      128
#define XB_XCNT(j)  (256  + 64 * (j))
#define XB_XSUB(j)  (1280 + 64 * (j))
#define XB_XGEN(j)  (2304 + 64 * (j))
#define XB_TOP      3328
#define XB_TOPGEN   3392
#define XCD_BAR_WORDS 3456
#define XB_SPIN_CAP (1u << 18)
__device__ __forceinline__ unsigned xb_ld(unsigned* p)              { return __hip_atomic_load(p, __ATOMIC_RELAXED, __HIP_MEMORY_SCOPE_AGENT); }
__device__ __forceinline__ unsigned xb_add(unsigned* p, unsigned v) { return __hip_atomic_fetch_add(p, v, __ATOMIC_RELAXED, __HIP_MEMORY_SCOPE_AGENT); }
__device__ __forceinline__ unsigned xb_xcc_id() { return (unsigned)__builtin_amdgcn_s_getreg((3 << 11) | 20) & 0xFu; }
#define XB_SPIN(cond, bar) do { unsigned _sp = 0; while (cond) { __builtin_amdgcn_s_sleep(1); \
    if ((++_sp & 255u) == 0u) { if (xb_ld(&(bar)[XB_TMO])) break; if (_sp > XB_SPIN_CAP) { atomicAdd(&(bar)[XB_TMO], 1u); break; } } } } while (0)
struct XcdBarrier { unsigned* bar; unsigned x; volatile LAS unsigned* st; };
__device__ __forceinline__ XcdBarrier xcd_barrier_post(unsigned* bar, volatile LAS unsigned* st) {
    XcdBarrier b; b.bar = bar; b.x = xb_xcc_id(); b.st = st;
    if (threadIdx.x == 0) (void)xb_add(&bar[XB_XCNT(b.x)], 1u);
    return b;
}
__device__ __forceinline__ void xcd_barrier_complete(unsigned* bar, unsigned x, unsigned& nloc, unsigned& nx) {
    const unsigned G = gridDim.x * gridDim.y * gridDim.z;
    unsigned sum, cnt, mine, sp = 0u;
    for (;;) {
        sum = 0u; cnt = 0u; mine = 0u;
#pragma unroll
        for (unsigned j = 0; j < 16; ++j) { const unsigned c = xb_ld(&bar[XB_XCNT(j)]); sum += c; cnt += (c > 0u) ? 1u : 0u; mine = (j == x) ? c : mine; }
        if (sum == G) break;
        __builtin_amdgcn_s_sleep(1);
        if ((++sp & 255u) == 0u) { if (xb_ld(&bar[XB_TMO])) break; if (sp > XB_SPIN_CAP) { atomicAdd(&bar[XB_TMO], 1u); break; } }
    }
    nloc = mine > 0u ? mine : 1u; nx = cnt > 0u ? cnt : 1u;
}
__device__ __forceinline__ void xcd_barrier(const XcdBarrier& b) {
    asm volatile("s_waitcnt vmcnt(0)" ::: "memory");
    __syncthreads();
    if (threadIdx.x == 0) {
        unsigned* bar = b.bar;
        __builtin_amdgcn_s_waitcnt(0);
        unsigned nloc = b.st[0], nx = b.st[1];
        if (nloc == 0u) { xcd_barrier_complete(bar, b.x, nloc, nx); b.st[0] = nloc; b.st[1] = nx; }
        const unsigned old = xb_add(&bar[XB_XSUB(b.x)], 1u);
        const unsigned gen = old / nloc;
        if (old + 1u == (gen + 1u) * nloc) {
            __builtin_amdgcn_fence(__ATOMIC_RELEASE, "agent");
            asm volatile("s_waitcnt vmcnt(0)" ::: "memory");
            const unsigned og = xb_add(&bar[XB_TOP], 1u);
            const unsigned tg = og / nx;
            if (og + 1u == (tg + 1u) * nx) xb_add(&bar[XB_TOPGEN], 1u);
            else XB_SPIN(xb_ld(&bar[XB_TOPGEN]) == tg, bar);
            __builtin_amdgcn_fence(__ATOMIC_ACQUIRE, "agent");
            xb_add(&bar[XB_XGEN(b.x)], 1u);
            asm volatile("s_waitcnt vmcnt(0)" ::: "memory");
        } else {
            XB_SPIN(xb_ld(&bar[XB_XGEN(b.x)]) == gen, bar);
            __builtin_amdgcn_fence(__ATOMIC_ACQUIRE, "agent");
            asm volatile("s_waitcnt vmcnt(0)" ::: "memory");
        }
    }
    __syncthreads();
}

struct Args { const float* in[22]; float* out; unsigned char* ws; int ph_lo, ph_hi; };
__device__ __forceinline__ const float* inp(LAS unsigned char* lds, int k) {
    volatile LAS unsigned* p = (volatile LAS unsigned*)(lds + PTR_OFF) + 2 * k;
    const unsigned lo = __builtin_amdgcn_readfirstlane(p[0]), hi = __builtin_amdgcn_readfirstlane(p[1]);
    return (const float*)(const GAS float*)(((unsigned long long)hi << 32) | lo);
}

__device__ __forceinline__ float wave_sum(float v) {
#pragma unroll
    for (int o = 1; o < 64; o <<= 1) v += __shfl_xor(v, o);
    return v;
}
__device__ __forceinline__ void tr_item(const float* __restrict__ W, int N, bf16_t* __restrict__ WT, int ldd, int k0, int n0, int drow0, int dcol0, LAS unsigned* scr, int lane) {
    const float* src = W + (size_t)k0 * N + n0 + lane;
#pragma unroll 8
    for (int kk = 0; kk < 64; ++kk) { const float a = src[(size_t)(2 * kk) * N], b = src[(size_t)(2 * kk + 1) * N]; scr[lane * 65 + kk] = cvt_pk_bf16(a, b); }
    LDS_WAIT(); asm volatile("" ::: "memory");
    const int q = lane & 15;
#pragma unroll 4
    for (int i = 0; i < 16; ++i) { const int n = 4 * i + (lane >> 4); const LAS unsigned* s = scr + n * 65 + 4 * q;
        u32x4 o; o.x = s[0]; o.y = s[1]; o.z = s[2]; o.w = s[3];
        *(u32x4*)(WT + (size_t)(drow0 + n) * ldd + dcol0 + 8 * q) = o; }
    LDS_WAIT(); asm volatile("" ::: "memory");
}

__device__ __forceinline__ void prologue_a(unsigned char* ws, LAS unsigned char* lds, int gw, int NGW, int wave, int lane) {
    LAS unsigned* scr = (LAS unsigned*)(lds + wave * 16640);
    constexpr int I13 = 32 * 160, I2 = 40 * 64, IIN = 32 * 140, IB = 8 * 64, IG = 2 * 256, IO = 32 * 64;
    constexpr int IL = 2 * I13 + 2 * I2 + IIN + 4 * IB + IG + IO;
    const float* p8 = inp(lds, 8); const float* p9 = inp(lds, 9); const float* p10 = inp(lds, 10); const float* p19 = inp(lds, 19); const float* p20 = inp(lds, 20); const float* p21 = inp(lds, 21);
    for (int it = gw; it < DEPTH * IL; it += NGW) {
        const int l = it / IL; int r = it % IL; unsigned char* wl = ws + WS_W + (size_t)l * WL_SIZE;
        if (r < 2 * I13) { const int k = r / I13; r %= I13; const int kb = r / 160, nb = r % 160, n0 = nb * 64;
            const int drow0 = n0 < DFF ? 256 * (n0 / 128) + (n0 % 128) : 256 * ((n0 - DFF) / 128) + 128 + ((n0 - DFF) % 128);
            tr_item(p8 + (size_t)(l * 2 + k) * DM * 2 * DFF, 2 * DFF, (bf16_t*)(wl + WL_W13) + (size_t)k * 2 * DFF * DM, DM, kb * 128, n0, drow0, kb * 128, scr, lane); continue; }
        r -= 2 * I13;
        if (r < 2 * I2) { const int k = r / I2; r %= I2; const int kb = r / 64, nb = r % 64;
            tr_item(p9 + (size_t)(l * 2 + k) * DFF * DM, DM, (bf16_t*)(wl + WL_W2) + (size_t)k * DM * DFF, DFF, kb * 128, nb * 64, nb * 64, kb * 128, scr, lane); continue; }
        r -= 2 * I2;
        if (r < IIN) { const int kb = r / 140, nb = r % 140;
            tr_item(p10 + (size_t)l * DM * NIN, NIN, (bf16_t*)(wl + WL_WIN), DM, kb * 128, nb * 64, nb * 64, kb * 128, scr, lane); continue; }
        r -= IIN;
        if (r < 4 * IB) { const int i = r / IB; r %= IB; const int kb = r / 64, nb = r % 64;
            tr_item(p19 + (size_t)(l * 4 + i) * 1024 * DM, DM, (bf16_t*)(wl + WL_WB), DM, kb * 128, nb * 64, nb * 64, i * 1024 + kb * 128, scr, lane); continue; }
        r -= 4 * IB;
        if (r < IG) { const int kb = r / 256, nb = r % 256;
            tr_item(p20 + (size_t)l * 256 * 16384, 16384, (bf16_t*)(wl + WL_GATE), 256, kb * 128, nb * 64, nb * 64, kb * 128, scr, lane); continue; }
        r -= IG;
        { const int kb = r / 64, nb = r % 64;
            tr_item(p21 + (size_t)l * DM * DM, DM, (bf16_t*)(wl + WL_WO), DM, kb * 128, nb * 64, nb * 64, kb * 128, scr, lane); }
    }
    const long gt = (long)gw * 64 + lane, NGT = (long)NGW * 64;
    { bf16_t* cs = (bf16_t*)(ws + WS_CS);
      for (long idx = gt; idx < (long)SEQ * 2048; idx += NGT) { const int k = (int)(idx >> 11), c8 = (int)(idx & 2047), tp = c8 * 8, part = tp >> 13, t0 = tp & 8191; float v[8];
#pragma unroll
          for (int e = 0; e < 8; ++e) { const float x = (float)((k * (t0 + e)) & 8191) * (1.f / 8192.f); v[e] = part ? __builtin_amdgcn_sinf(x) : __builtin_amdgcn_cosf(x); }
          u32x4 w; w.x = cvt_pk_bf16(v[0], v[1]); w.y = cvt_pk_bf16(v[2], v[3]); w.z = cvt_pk_bf16(v[4], v[5]); w.w = cvt_pk_bf16(v[6], v[7]);
          *(u32x4*)(cs + idx * 8) = w; } }
    { bf16_t* ct = (bf16_t*)(ws + WS_CSCT); bf16_t* cx = (bf16_t*)(ws + WS_CSCTX);
      for (long idx = gt; idx < 512 * 256; idx += NGT) { const int m = (int)(idx >> 8), c = (int)(idx & 255); const float x = (float)(((m & 255) * c) & 255) * (1.f / 256.f);
          const float v = (m < 256) ? __builtin_amdgcn_cosf(x) : -__builtin_amdgcn_sinf(x); ct[idx] = (bf16_t)(cvt_pk_bf16(v, 0.f) & 0xffffu); }
      for (long idx = gt; idx < 256 * 512; idx += NGT) { const int k = (int)(idx >> 9), tp = (int)(idx & 511); const float x = (float)((k * (tp & 255)) & 255) * (1.f / 256.f);
          const float v = (tp < 256) ? __builtin_amdgcn_cosf(x) : __builtin_amdgcn_sinf(x); cx[idx] = (bf16_t)(cvt_pk_bf16(v, 0.f) & 0xffffu); } }
    { float* rp = (float*)(ws + WS_ROPE);
      for (long idx = gt; idx < 128 * 32; idx += NGT) { const int pos = (int)(idx >> 5), i = (int)(idx & 31); const float inv = exp2f(-(float)(2 * i) * (1.f / 64.f) * 13.287712379549449f);
          float rev = (float)pos * inv * 0.15915494309189535f; rev -= floorf(rev); rp[idx] = __builtin_amdgcn_cosf(rev); rp[4096 + idx] = __builtin_amdgcn_sinf(rev); }
      for (long idx = gt; idx < 128 * 16; idx += NGT) { const int pos = (int)(idx >> 4), i = (int)(idx & 15); const float inv = exp2f(-(float)(2 * i) * (1.f / 32.f) * 13.287712379549449f);
          float rev = (float)pos * inv * 0.15915494309189535f; rev -= floorf(rev); rp[8192 + idx] = __builtin_amdgcn_cosf(rev); rp[8192 + 2048 + idx] = __builtin_amdgcn_sinf(rev); } }
    { float* xs = (float*)(ws + WS_XS); const float* pctx = inp(lds, 2); const float* px = inp(lds, 0);
      for (int r = gw; r < T; r += NGW) { const int b = r / TB, i = r % TB; const float* src = (i < CTXL) ? pctx + (size_t)(b * CTXL + i) * DM : px + (size_t)(b * SEQ + i - CTXL) * DM;
          const f32x4* s4 = (const f32x4*)src + lane; f32x4* d4 = (f32x4*)(xs + (size_t)r * DM) + lane;
#pragma unroll
          for (int j = 0; j < 16; ++j) d4[64 * j] = s4[64 * j]; } }
    { float* t1 = (float*)(ws + WS_T1P); const float* pc = inp(lds, 1); const float* pcc = inp(lds, 3); const float* pdn = inp(lds, 5);
      for (int it = gw; it < DEPTH * 64; it += NGW) { const int l = it >> 6, ch = it & 63; f32x4 acc0 = {0, 0, 0, 0}, acc1 = acc0, acc2 = acc0;
          const float* dn = pdn + ((size_t)l * DM + ch * 64) * 256 + 4 * lane;
          for (int d = 0; d < 64; ++d) { const int dd = ch * 64 + d; const f32x4 row = *(const f32x4*)(dn + (size_t)d * 256);
              const float c0 = pc[dd], c1 = pc[DM + dd], c2 = pcc[dd];
              acc0 += row * (c0 / (1.f + __expf(-c0))); acc1 += row * (c1 / (1.f + __expf(-c1))); acc2 += row * (c2 / (1.f + __expf(-c2))); }
          float* o = t1 + ((size_t)(l * 64 + ch) * 3) * 256 + 4 * lane; *(f32x4*)o = acc0; *(f32x4*)(o + 256) = acc1; *(f32x4*)(o + 512) = acc2; } }
    if (gw == 0) { float* lm = (float*)(ws + WS_LAM); const float* pdl = inp(lds, 17);
        for (int l = 0; l < DEPTH; ++l) { const float* dl = pdl + l * 256; const float s1 = wave_sum(dl[lane] * dl[64 + lane]), s2 = wave_sum(dl[128 + lane] * dl[192 + lane]);
            const float li = 0.8f - 0.6f * expf(-0.3f * (float)l); if (lane == 0) { lm[l] = expf(s1) - expf(s2) + li; lm[4 + l] = 1.f - li; } } }
}
__device__ __forceinline__ void prologue_b(unsigned char* ws, LAS unsigned char* lds, int gw, int NGW, int wave, int lane) {
    LAS float* tl = (LAS float*)(lds + wave * 4096);
    const float* t1 = (const float*)(ws + WS_T1P); float* mod = (float*)(ws + WS_MOD); const float* pb7 = inp(lds, 7); const float* pup = inp(lds, 6);
    for (int it = gw; it < DEPTH * 144; it += NGW) { const int l = it / 144, n0 = (it % 144) * 256 + 4 * lane;
        f32x4 t0 = {0, 0, 0, 0}, t1v = t0, t2 = t0;
        for (int ch = 0; ch < 64; ++ch) { const float* p = t1 + ((size_t)(l * 64 + ch) * 3) * 256 + 4 * lane; t0 += *(const f32x4*)p; t1v += *(const f32x4*)(p + 256); t2 += *(const f32x4*)(p + 512); }
        *(LAS f32x4*)(tl + 4 * lane) = t0; *(LAS f32x4*)(tl + 256 + 4 * lane) = t1v; *(LAS f32x4*)(tl + 512 + 4 * lane) = t2;
        LDS_WAIT(); asm volatile("" ::: "memory");
        const f32x4 bb = *(const f32x4*)(pb7 + (size_t)l * NMOD * DM + n0); f32x4 acc0 = bb, acc1 = bb, acc2 = bb;
        const float* up = pup + (size_t)l * 256 * NMOD * DM + n0;
#pragma unroll 4
        for (int j = 0; j < 256; ++j) { const f32x4 row = *(const f32x4*)(up + (size_t)j * NMOD * DM); acc0 += row * tl[j]; acc1 += row * tl[256 + j]; acc2 += row * tl[512 + j]; }
        float* o = mod + (size_t)(l * 3) * NMOD * DM + n0; *(f32x4*)o = acc0; *(f32x4*)(o + NMOD * DM) = acc1; *(f32x4*)(o + 2 * NMOD * DM) = acc2;
        LDS_WAIT(); asm volatile("" ::: "memory"); }
}
__device__ __forceinline__ void norm_phase(unsigned char* ws, LAS unsigned char* lds, int l, int k, int gw, int NGW, int tid, int lane) {
    asm volatile("" : "+v"(lane), "+v"(tid));
    LAS float* gp = (LAS float*)lds; LAS float* sh = gp + 3 * DM;
    const float* mod = (const float*)(ws + WS_MOD) + (size_t)(l * 3) * NMOD * DM; const float* g = inp(lds, 4) + (size_t)(l * 3 + k) * DM;
    for (int i = tid; i < 3 * DM; i += NTHREADS) { const int v = i / DM, c = i % DM; gp[i] = g[c] * (1.f + mod[(size_t)v * NMOD * DM + (3 * k + 1) * DM + c]); sh[i] = mod[(size_t)v * NMOD * DM + (3 * k) * DM + c]; }
    __syncthreads();
    const float* xs = (const float*)(ws + WS_XS); bf16_t* H = (bf16_t*)(ws + WS_H);
    for (int r = gw; r < T; r += NGW) { const int b = r / TB, i = r % TB, v = (i < CTXL) ? 2 : b;
        const f32x4* xr = (const f32x4*)(xs + (size_t)r * DM) + lane; f32x4 x[16]; float s = 0.f;
#pragma unroll
        for (int j = 0; j < 16; ++j) { x[j] = xr[64 * j]; s += (x[j][0] * x[j][0] + x[j][1] * x[j][1]) + (x[j][2] * x[j][2] + x[j][3] * x[j][3]); }
        const float rstd = 1.f / sqrtf(wave_sum(s) * (1.f / DM) + EPS);
        u32x2* o = (u32x2*)(H + (size_t)r * DM) + lane;
#pragma unroll
        for (int j = 0; j < 16; ++j) { const f32x4 gg = *(const LAS f32x4*)(gp + v * DM + 4 * lane + 256 * j), ss = *(const LAS f32x4*)(sh + v * DM + 4 * lane + 256 * j);
            const f32x4 y = x[j] * rstd * gg + ss; u32x2 w; w.x = cvt_pk_bf16(y[0], y[1]); w.y = cvt_pk_bf16(y[2], y[3]); o[64 * j] = w; } }
    __syncthreads();
}
__device__ __forceinline__ void ld16(const bf16_t* p, float (&x)[16]) { const u32x4 a = *(const u32x4*)p, b = *(const u32x4*)(p + 8);
    x[0] = bf_lo(a.x); x[1] = bf_hi(a.x); x[2] = bf_lo(a.y); x[3] = bf_hi(a.y); x[4] = bf_lo(a.z); x[5] = bf_hi(a.z); x[6] = bf_lo(a.w); x[7] = bf_hi(a.w);
    x[8] = bf_lo(b.x); x[9] = bf_hi(b.x); x[10] = bf_lo(b.y); x[11] = bf_hi(b.y); x[12] = bf_lo(b.z); x[13] = bf_hi(b.z); x[14] = bf_lo(b.w); x[15] = bf_hi(b.w); }
__device__ __forceinline__ void st16(bf16_t* p, const float (&x)[16]) { u32x4 a, b;
    a.x = cvt_pk_bf16(x[0], x[1]); a.y = cvt_pk_bf16(x[2], x[3]); a.z = cvt_pk_bf16(x[4], x[5]); a.w = cvt_pk_bf16(x[6], x[7]);
    b.x = cvt_pk_bf16(x[8], x[9]); b.y = cvt_pk_bf16(x[10], x[11]); b.z = cvt_pk_bf16(x[12], x[13]); b.w = cvt_pk_bf16(x[14], x[15]); *(u32x4*)p = a; *(u32x4*)(p + 8) = b; }
template <int HD>
__device__ __forceinline__ void normrope(float (&x)[16], int lane, const float* __restrict__ gain, bool rope, int rowpos, int colpos, const float* __restrict__ rp) {
    float s = 0.f;
#pragma unroll
    for (int e = 0; e < 16; ++e) s += x[e] * x[e];
    s += __shfl_xor(s, 1); s += __shfl_xor(s, 2); if (HD == 128) s += __shfl_xor(s, 4);
    const float rstd = 1.f / sqrtf(s * (1.f / HD) + EPS);
    const int j = lane & (HD / 16 - 1);
#pragma unroll
    for (int e = 0; e < 16; ++e) x[e] = x[e] * rstd * gain[j * 16 + e];
    constexpr int PX = (HD == 128) ? 2 : 1;
    float y[16];
#pragma unroll
    for (int e = 0; e < 16; ++e) y[e] = __shfl_xor(x[e], PX);
    if (rope) {
        const int part = (HD == 128) ? (j >> 2) : (j >> 1), role = (HD == 128) ? ((j >> 1) & 1) : (j & 1), fb = (HD == 128) ? 16 * (j & 1) : 0, pos = part ? colpos : rowpos;
        const float* ct = rp + ((HD == 128) ? 0 : 8192) + pos * (HD / 4) + fb; const float* st = ct + ((HD == 128) ? 4096 : 2048);
#pragma unroll
        for (int e = 0; e < 16; ++e) { const float c = ct[e], sn = st[e]; x[e] = role ? (x[e] * c + y[e] * sn) : (x[e] * c - y[e] * sn); }
    }
}
__device__ __forceinline__ void p6_rows(unsigned char* ws, LAS unsigned char* lds, int l, int gw, int NGW, int lane) {
    asm volatile("" : "+v"(lane));
    const bf16_t* PC = (const bf16_t*)(ws + WS_PIECES); const float* rp = (const float*)(ws + WS_ROPE);
    bf16_t* QS = (bf16_t*)(ws + WS_QS); bf16_t* KS = (bf16_t*)(ws + WS_KS); bf16_t* QD = (bf16_t*)(ws + WS_QD); bf16_t* KD = (bf16_t*)(ws + WS_KD); bf16_t* OB = (bf16_t*)(ws + WS_OB);
    const float* gsq = inp(lds, 12) + l * 128; const float* gsk = inp(lds, 13) + l * 128; const float* gdq = inp(lds, 15) + l * 64; const float* gdk = inp(lds, 16) + l * 64; const float* cw = inp(lds, 11) + (size_t)l * 3 * 1024;
    for (int r = gw; r < T; r += NGW) { const int i = r % TB; const bool lat = i >= CTXL; const int t = i - CTXL, rowpos = (t >> 6) & 127, colpos = t & 63;
        const bf16_t* P = PC + (size_t)r * NIN; float x[16];
        ld16(P + C_SQ + 16 * lane, x); normrope<128>(x, lane, gsq, lat, rowpos, colpos, rp); st16(QS + (size_t)r * 1024 + 16 * lane, x);
        ld16(P + C_SK + 16 * (lane & 15), x); normrope<128>(x, lane, gsk, lat, rowpos, colpos, rp); if (lane < 16) st16(KS + (size_t)r * 256 + 16 * lane, x);
        ld16(P + C_DQ + 16 * lane, x); normrope<64>(x, lane, gdq, lat, rowpos, colpos, rp); st16(QD + (size_t)r * 1024 + 16 * lane, x);
        ld16(P + C_DK + 16 * lane, x); normrope<64>(x, lane, gdk, lat, rowpos, colpos, rp); st16(KD + (size_t)r * 1024 + 16 * lane, x);
        { const int seg_lo = lat ? CTXL : 0, seg_hi = lat ? TB : CTXL; float gc[16], vv[16], y[16];
          ld16(P + C_CONVC + 16 * lane, gc); ld16(P + C_CONVV + 16 * lane, vv);
#pragma unroll
          for (int e = 0; e < 16; ++e) y[e] = gc[e] * vv[e] * cw[1024 + 16 * lane + e];
          if (i - 1 >= seg_lo) { ld16(P - NIN + C_CONVC + 16 * lane, gc); ld16(P - NIN + C_CONVV + 16 * lane, vv);
#pragma unroll
              for (int e = 0; e < 16; ++e) y[e] += gc[e] * vv[e] * cw[16 * lane + e]; }
          if (i + 1 < seg_hi) { ld16(P + NIN + C_CONVC + 16 * lane, gc); ld16(P + NIN + C_CONVV + 16 * lane, vv);
#pragma unroll
              for (int e = 0; e < 16; ++e) y[e] += gc[e] * vv[e] * cw[2048 + 16 * lane + e]; }
          ld16(P + C_CONVB + 16 * lane, gc);
#pragma unroll
          for (int e = 0; e < 16; ++e) y[e] *= gc[e];
          st16(OB + (size_t)r * DM + 1024 + 16 * lane, y); }
    }
}

constexpr int PH_PER_LAYER = 12, N_PHASES = 2 + DEPTH * PH_PER_LAYER;
__global__ void __launch_bounds__(NTHREADS, 2) fwd_kernel(Args args) {
    extern __shared__ __attribute__((aligned(16))) unsigned char lds_raw[];
    LAS unsigned char* lds = (LAS unsigned char*)lds_raw;
    volatile LAS unsigned* MISC = (volatile LAS unsigned*)(lds + MISC_OFF);
    const int tid = threadIdx.x, lane = tid & 63, wave = __builtin_amdgcn_readfirstlane(tid >> 6);
    const int G = gridDim.x, bx = blockIdx.x;
    const int vcu = (G % 8 == 0) ? (bx % 8) * (G / 8) + bx / 8 : bx;
    const int gw = vcu * NWAVES + wave, NGW = G * NWAVES;
    unsigned char* ws = args.ws;
    unsigned* ctl = (unsigned*)(ws + WS_CTL);
    for (int u = tid; u < 64; u += NTHREADS) MISC[u] = 0u;
    if (tid < 22) ((LAS unsigned long long*)(lds + PTR_OFF))[tid] = (unsigned long long)(uintptr_t)args.in[tid];
    __syncthreads();
    XcdBarrier bar; bar.bar = ctl + CW_BAR; bar.x = 0; bar.st = nullptr;
    if (!MK_PER_PHASE) bar = xcd_barrier_post(ctl + CW_BAR, MISC + 8);
    const int lo = args.ph_lo, hi = args.ph_hi;
#ifndef ONLY_SITE
#define ONLY_SITE -1
#endif
#define SITE(s) (ONLY_SITE < 0 || ONLY_SITE == (s))
#ifndef ONLY_SUB
#define ONLY_SUB -1
#endif
#define SUB(s) (ONLY_SUB < 0 || ONLY_SUB == (s))
#define IN(k) (lo <= (k) && (k) < hi)
#define SEAM(k) do { if (IN(k) && IN((k) + 1)) { if (MK_PER_PHASE) { if (tid == 0) __hip_atomic_store(ctl + 1, 0xBAD00000u | (unsigned)(k), RLX_AGENT); } else xcd_barrier(bar); } } while (0)

    if (SITE(0) && IN(0)) { prologue_a(ws, lds, gw, NGW, wave, lane); } SEAM(0);
    if (SITE(1) && IN(1)) { prologue_b(ws, lds, gw, NGW, wave, lane); } SEAM(1);

#define H_ ((bf16_t*)(ws + WS_H))
#define ACT_ ((bf16_t*)(ws + WS_ACT))
#define PIECES_ ((bf16_t*)(ws + WS_PIECES))
#define XS_ ((float*)(ws + WS_XS))
#define OB_ ((bf16_t*)(ws + WS_OB))
#define SIG_ ((bf16_t*)(ws + WS_SIG))
#define MG_ ((bf16_t*)(ws + WS_MG))
#define WL_ (ws + WS_W + (size_t)l * WL_SIZE)
#define MODL_ ((const float*)(ws + WS_MOD) + (size_t)(l * 3) * NMOD * DM)
    for (int it = 0; it < 2 * DEPTH; ++it) {
        const int l = it >> 1, hf = it & 1, kidx = hf ? 2 : 0, pb = 2 + PH_PER_LAYER * l + (hf ? 9 : 0);
        if (SITE(2) && IN(pb + 0)) { norm_phase(ws, lds, l, kidx, gw, NGW, tid, lane); } SEAM(pb + 0);
        if (SITE(3) && IN(pb + 1)) {
            pg8::Gemm g{H_, (const bf16_t*)(WL_ + WL_W13) + (size_t)hf * 2 * DFF * DM, DM, DM, DM, 0, 0}; pg8::Order S; S.init(T / 256, 2 * DFF / 256, 1, G, bx, 1);
            pg8::EpiSwiGLU E{ACT_, DFF};
            pg8::gemm_phase<pg8::EpiSwiGLU, true, true>(lds, g, S, E);
        } SEAM(pb + 1);
        if (SITE(4) && IN(pb + 2)) {
            pg8::Gemm g{ACT_, (const bf16_t*)(WL_ + WL_W2) + (size_t)hf * DM * DFF, DFF, DFF, DFF, 0, 0}; pg8::Order S; S.init(T / 256, DM / 256, 1, G, bx, 1);
            pg8::EpiResid<true> E{XS_, MODL_ + (size_t)(kidx * 3 + 2) * DM, args.out, (it == 2 * DEPTH - 1) ? 1 : 0};
            pg8::gemm_phase<pg8::EpiResid<true>, true, true>(lds, g, S, E);
        } SEAM(pb + 2);
        if (hf) continue;
        const int mb = pb + 3;
        if (SITE(5) && IN(mb + 0)) { norm_phase(ws, lds, l, 1, gw, NGW, tid, lane); } SEAM(mb + 0);
        if (SITE(6) && IN(mb + 1)) {
            pg8::Gemm g{H_, (const bf16_t*)(WL_ + WL_WIN), DM, DM, DM, 0, 0}; pg8::Order S; S.init(T / 256, NIN / 256, 1, G, bx, 1);
            pg8::EpiBf16 E{PIECES_, NIN, 0, 0, 1.f};
            pg8::gemm_phase<pg8::EpiBf16, true, true>(lds, g, S, E);
        } SEAM(mb + 1);
        if (SITE(7) && IN(mb + 2)) {
            if (SUB(0)) {
                pg8::Gemm g{(const bf16_t*)(ws + WS_CSCT), PIECES_ + C_FOUR, 256, 256, NIN, 0, 256}; pg8::Order S; S.init(2, T / 256, 4, G, bx, 1);
                pg8::EpiChan E{(bf16_t*)(ws + WS_ABT), (bf16_t*)(ws + WS_ABTC)};
                pg8::gemm_phase<pg8::EpiChan, true, true>(lds, g, S, E);
            }
            if (SUB(1)) {
                pg8::Gemm g{PIECES_ + C_Z, (const bf16_t*)(WL_ + WL_GATE), 256, NIN, 256, 0, 0}; pg8::Order S; S.init(T / 256, 16384 / 256, 1, G, bx, 1);
                pg8::EpiSig E{SIG_, 16384};
                pg8::gemm_phase<pg8::EpiSig, true, true>(lds, g, S, E);
            }
            if (SUB(2)) p6_rows(ws, lds, l, gw, NGW, lane);
        } SEAM(mb + 2);
        if (SITE(8) && IN(mb + 3)) {
            if (SUB(0)) {
                pg8::Gemm g{(const bf16_t*)(ws + WS_CS), (const bf16_t*)(ws + WS_ABT), 16384, 16384, 16384, 0, (long)1024 * 16384}; pg8::Order S; S.init(SEQ / 256, 4, 2, G, bx, 1);
                pg8::EpiBf16 E{OB_, DM, CTXL, TB, 6.9053396600248786e-4f};
                pg8::gemm_phase<pg8::EpiBf16, true, true>(lds, g, S, E);
            }
            if (SUB(1)) {
                pg8::Gemm g{(const bf16_t*)(ws + WS_CSCTX), (const bf16_t*)(ws + WS_ABTC), 512, 512, 512, 0, (long)1024 * 512}; pg8::Order S; S.init(1, 4, 2, G, bx, 1);
                pg8::EpiBf16 E{OB_, DM, 0, TB, 1.f / 256.f};
                pg8::gemm_phase<pg8::EpiBf16, true, true>(lds, g, S, E);
            }
            __syncthreads();
            const int wid = wave;
            const float* lamp = (const float*)(ws + WS_LAM); const float lam = lamp[l], oml = lamp[4 + l];
            if (SUB(2)) for (int u = bx; u < 512 + 16; u += G) {
                int b, h, q0, NT;
                if (u < 512) { b = u >> 8; h = (u >> 5) & 7; q0 = CTXL + (u & 31) * 256; NT = TB / 64; } else { const int v = u - 512; b = v >> 3; h = v & 7; q0 = 0; NT = CTXL / 64; }
                const size_t rb = (size_t)b * TB; float* O1 = (float*)(ws + WS_O1);
                for (int c = 0; c < 2; ++c) {
                    f32x16 o[4];
                    att::attn_unit<64, false, 1024, 1024, NIN>((const bf16_t*)(ws + WS_QD) + (rb + q0) * 1024 + (2 * h + c) * 64, (const bf16_t*)(ws + WS_KD) + rb * 1024 + (2 * h + c) * 64,
                                              (const bf16_t*)(ws + WS_PIECES) + rb * NIN + C_DV + h * 128, NT, 0, 0, 0, -1e30f, 0.f, (LAS char*)lds, o);
                    int ln = lane; asm volatile("" : "+v"(ln));
                    const int r32 = ln & 31, hi5 = ln >> 5;
                    float* O1b = O1 + (rb + q0 + wid * 32) * 1024 + h * 128;
                    const unsigned lo1 = (unsigned)(4 * hi5 * 1024 + r32);
                    if (c == 0) {
#pragma unroll
                        for (int r = 0; r < 16; ++r) { float* p = O1b + ((r & 3) + 8 * (r >> 2)) * 1024 + lo1;
#pragma unroll
                            for (int d = 0; d < 4; ++d) p[d * 32] = o[d][r];
                            asm volatile("" ::: "memory"); }
                    } else {
                        const float* sub = inp(lds, 18) + l * 128; float sg[4];
#pragma unroll
                        for (int d = 0; d < 4; ++d) sg[d] = sub[d * 32 + r32] * oml;
                        bf16_t* OBb = (bf16_t*)(ws + WS_OB) + (rb + q0 + wid * 32) * DM + 3072 + h * 128;
                        const unsigned lo2 = (unsigned)(4 * hi5 * DM + r32);
#pragma unroll
                        for (int r = 0; r < 16; ++r) { const float* p = O1b + ((r & 3) + 8 * (r >> 2)) * 1024 + lo1; float dv[4], ss = 0.f;
#pragma unroll
                            for (int d = 0; d < 4; ++d) { dv[d] = p[d * 32] - lam * o[d][r]; ss += dv[d] * dv[d]; }
                            ss += __shfl_xor(ss, 1); ss += __shfl_xor(ss, 2); ss += __shfl_xor(ss, 4); ss += __shfl_xor(ss, 8); ss += __shfl_xor(ss, 16);
                            const float rstd = 1.f / sqrtf(ss * (1.f / 128.f) + EPS); bf16_t* q = OBb + ((r & 3) + 8 * (r >> 2)) * DM + lo2;
#pragma unroll
                            for (int d = 0; d < 4; ++d) q[d * 32] = (bf16_t)(cvt_pk_bf16(dv[d] * rstd * sg[d], 0.f) & 0xffffu);
                            asm volatile("" ::: "memory"); }
                    }
                }
            }
            if (SUB(3)) for (int u = bx; u < 512 + 16; u += G) {
                int b, h, q0, NT, i0;
                if (u < 512) { b = u >> 8; h = (u >> 5) & 7; i0 = (u & 31) * 256; q0 = CTXL + i0; NT = 12; } else { const int v = u - 512; b = v >> 3; h = v & 7; i0 = 0; q0 = 0; NT = 4; }
                const size_t rb = (size_t)b * TB; const float sink = inp(lds, 14)[l * 8 + h];
                f32x16 o[4];
                att::attn_unit<128, true, 1024, 256, NIN>((const bf16_t*)(ws + WS_QS) + (rb + q0) * 1024 + h * 128, (const bf16_t*)(ws + WS_KS) + rb * 256 + (h >> 2) * 128,
                                          (const bf16_t*)(ws + WS_PIECES) + rb * NIN + C_SV + (h >> 2) * 128, NT, 4, i0 - 128, i0, sink * 11.313708498984761f, 1.f, (LAS char*)lds, o);
                int ln = lane; asm volatile("" : "+v"(ln));
                const int r32 = ln & 31, hi5 = ln >> 5;
                bf16_t* OBb = (bf16_t*)(ws + WS_OB) + (rb + q0 + wid * 32) * DM + 2048 + h * 128;
                const unsigned lo2 = (unsigned)(4 * hi5 * DM + r32);
#pragma unroll
                for (int r = 0; r < 16; ++r) { bf16_t* q = OBb + ((r & 3) + 8 * (r >> 2)) * DM + lo2;
#pragma unroll
                    for (int d = 0; d < 4; ++d) q[d * 32] = (bf16_t)(cvt_pk_bf16(o[d][r], 0.f) & 0xffffu);
                    asm volatile("" ::: "memory"); }
            }
        } SEAM(mb + 3);
        if (SITE(9) && IN(mb + 4)) {
            pg8::Gemm g{OB_, (const bf16_t*)(WL_ + WL_WB), 1024, DM, DM, 1024, 1024}; pg8::Order S; S.init(T / 256, DM / 256, 1, G, bx, 4);
            pg8::EpiMerge E{SIG_, (float*)(ws + WS_PART), MG_};
            pg8::gemm_phase<pg8::EpiMerge, true, true>(lds, g, S, E);
        } SEAM(mb + 4);
        if (SITE(10) && IN(mb + 5)) {
            pg8::Gemm g{MG_, (const bf16_t*)(WL_ + WL_WO), DM, DM, DM, 0, 0}; pg8::Order S; S.init(T / 256, DM / 256, 1, G, bx, 1);
            pg8::EpiResid<false> E{XS_, MODL_ + (size_t)5 * DM, args.out, 0};
            pg8::gemm_phase<pg8::EpiResid<false>, true, true>(lds, g, S, E);
        } SEAM(mb + 5);
    }
#undef IN
#undef SEAM
}

#ifndef DBG_NRUN
#define DBG_NRUN 0
#endif
struct DbgSeg { size_t off, n; int bf16; };
#ifndef DBG_SEGS
#define DBG_SEGS {WS_SIG, (size_t)T * 16384, 1}
#endif
__global__ void dbg_dump(const unsigned char* ws, float* out, size_t nout) {
    const DbgSeg segs[] = {DBG_SEGS}; constexpr int NS = sizeof(segs) / sizeof(segs[0]);
    for (size_t i = (size_t)blockIdx.x * blockDim.x + threadIdx.x; i < nout; i += (size_t)gridDim.x * blockDim.x) {
        size_t j = i; int k = 0;
#pragma unroll
        for (int q = 0; q < NS - 1; ++q) if (k == q && j >= segs[q].n) { j -= segs[q].n; k = q + 1; }
        j = j % segs[k].n;
        float v = 0.f;
#pragma unroll
        for (int q = 0; q < NS; ++q) if (k == q) v = segs[q].bf16 ? __uint_as_float((unsigned)((const bf16_t*)(ws + segs[q].off))[j] << 16) : ((const float*)(ws + segs[q].off))[j];
        out[i] = v;
    }
}
extern "C" void kernel_launch(void* const* d_in, const int* in_sizes, int n_in, void* d_out, int out_size, void* d_ws, size_t ws_size, hipStream_t stream) {
    static int grid = 0;
    if (grid == 0) {
        if (n_in != 22 || out_size != NBATCH * SEQ * DM || ws_size < WS_END) { fprintf(stderr, "kernel_launch: unexpected shapes: n_in %d out %d ws %zu (need %zu)\n", n_in, out_size, ws_size, (size_t)WS_END); grid = -1; return; }
        int dev = 0, cus = 0, per_cu = 0;
        if (hipGetDevice(&dev) != hipSuccess || hipDeviceGetAttribute(&cus, hipDeviceAttributeMultiprocessorCount, dev) != hipSuccess) { grid = -1; return; }
        if (hipFuncSetAttribute((const void*)fwd_kernel, hipFuncAttributeMaxDynamicSharedMemorySize, LDS_BYTES) != hipSuccess) { fprintf(stderr, "kernel_launch: hipFuncSetAttribute failed\n"); grid = -1; return; }
        if (hipOccupancyMaxActiveBlocksPerMultiprocessor(&per_cu, (const void*)fwd_kernel, NTHREADS, LDS_BYTES) != hipSuccess || per_cu < 1) { fprintf(stderr, "kernel_launch: occupancy query says %d\n", per_cu); }
        (void)hipGetLastError();
        grid = cus;
    }
    if (grid < 0) return;
    (void)hipMemsetAsync((char*)d_ws + WS_CTL, 0, CTL_ZERO_BYTES, stream);
    Args a{};
    for (int i = 0; i < 22; ++i) a.in[i] = (const float*)d_in[i];
    a.out = (float*)d_out; a.ws = (unsigned char*)d_ws;
#if DBG_NRUN > 0
    for (int p = 0; p < DBG_NRUN; ++p) { a.ph_lo = p; a.ph_hi = p + 1; hipLaunchKernelGGL(fwd_kernel, dim3(grid), dim3(NTHREADS), LDS_BYTES, stream, a); }
    hipLaunchKernelGGL(dbg_dump, dim3(2048), dim3(256), 0, stream, (const unsigned char*)d_ws, (float*)d_out, (size_t)out_size);
#elif MK_PER_PHASE
    for (int p = 0; p < N_PHASES; ++p) { a.ph_lo = p; a.ph_hi = p + 1; hipLaunchKernelGGL(fwd_kernel, dim3(grid), dim3(NTHREADS), LDS_BYTES, stream, a); }
#else
    a.ph_lo = 0; a.ph_hi = N_PHASES;
    hipLaunchKernelGGL(fwd_kernel, dim3(grid), dim3(NTHREADS), LDS_BYTES, stream, a);
#endif
    const hipError_t le = hipPeekAtLastError();
    if (le != hipSuccess) fprintf(stderr, "kernel_launch: launch failed: %s\n", hipGetErrorName(le));
}
```

```cpp
#include <hip/hip_runtime.h>
#include <cstdio>
#include <cstdint>

#ifndef MK_PER_PHASE
#define MK_PER_PHASE 0
#endif

#define LAS __attribute__((address_space(3)))
#define GAS __attribute__((address_space(1)))
typedef unsigned short bf16_t;
typedef short bf16x8 __attribute__((ext_vector_type(8)));
typedef short s16x4 __attribute__((ext_vector_type(4)));
typedef float f32x2 __attribute__((ext_vector_type(2)));
typedef float f32x4 __attribute__((ext_vector_type(4)));
typedef float f32x16 __attribute__((ext_vector_type(16)));
typedef unsigned u32x2 __attribute__((ext_vector_type(2)));
typedef unsigned u32x4 __attribute__((ext_vector_type(4)));

constexpr int DM = 4096, NBATCH = 2, SEQ = 8192, DEPTH = 4, CTXL = 256, TB = CTXL + SEQ, T = NBATCH * TB, DFF = 5120, NIN = 8960, NMOD = 9;
constexpr int PANB = TB / 256;
constexpr int C_FOUR = 0, C_CONVB = 1024, C_CONVC = 2048, C_CONVV = 3072, C_SQ = 4096, C_SK = 5120, C_SV = 5376, C_DQ = 5632, C_DK = 6656, C_DV = 7680, C_Z = 8704;
constexpr float EPS = 1e-6f;
constexpr int NWAVES = 8, NTHREADS = 512;

constexpr size_t MiB = 1u << 20;
constexpr size_t WS_CTL = 0, CTL_ZERO_BYTES = 64 * 1024;
constexpr size_t WS_ROPE = 1 * MiB;
constexpr size_t WS_LAM = 1 * MiB + 512 * 1024;
constexpr size_t WS_T1P = 2 * MiB;
constexpr size_t WS_MOD = 3 * MiB;
constexpr size_t WS_CSCT = 5 * MiB;
constexpr size_t WS_CSCTX = 5 * MiB + 512 * 1024;
constexpr size_t WS_CS = 6 * MiB;
constexpr size_t WS_W = 262 * MiB;
constexpr size_t WL_W13 = 0, WL_W2 = 160 * MiB, WL_WIN = 240 * MiB, WL_WB = 310 * MiB, WL_GATE = 342 * MiB, WL_WO = 350 * MiB, WL_SIZE = 382 * MiB;
constexpr size_t WS_XS = WS_W + DEPTH * WL_SIZE;
constexpr size_t WS_H = WS_XS + 264 * MiB;
constexpr size_t WS_ACT = WS_H + 132 * MiB;
constexpr size_t WS_PIECES = WS_ACT + 165 * MiB;
constexpr size_t WS_QS = WS_PIECES + 289 * MiB;
constexpr size_t WS_KS = WS_QS + 33 * MiB;
constexpr size_t WS_QD = WS_KS + 9 * MiB;
constexpr size_t WS_KD = WS_QD + 33 * MiB;
constexpr size_t WS_ABT = WS_KD + 33 * MiB;
constexpr size_t WS_ABTC = WS_ABT + 64 * MiB;
constexpr size_t WS_OB = WS_ABTC + 2 * MiB;
constexpr size_t WS_SIG = WS_OB + 132 * MiB;
constexpr size_t WS_PART = WS_SIG + 528 * MiB;
constexpr size_t WS_MG = WS_PART + 264 * MiB;
constexpr size_t WS_O1 = WS_MG + 132 * MiB;
constexpr size_t WS_END = WS_O1 + 66 * MiB;
constexpr int CW_BAR = 4096;

constexpr int LDS_BYTES = 147456;
constexpr int MISC_OFF = 144 * 1024 - 256;
constexpr int PTR_OFF = MISC_OFF - 256;

#define RLX_AGENT __ATOMIC_RELAXED, __HIP_MEMORY_SCOPE_AGENT
#define LDS_WAIT() asm volatile("s_waitcnt lgkmcnt(0)" ::: "memory")
#define VM_WAIT() asm volatile("s_waitcnt vmcnt(0)" ::: "memory")
typedef __bf16 bf16x2_t __attribute__((ext_vector_type(2)));
__device__ __forceinline__ unsigned cvt_pk_bf16(float lo, float hi) { const f32x2 v = {lo, hi}; const bf16x2_t b = __builtin_convertvector(v, bf16x2_t); return __builtin_bit_cast(unsigned, b); }
__device__ __forceinline__ float bf_lo(unsigned w) { return __uint_as_float(w << 16); }
__device__ __forceinline__ float bf_hi(unsigned w) { return __uint_as_float(w & 0xffff0000u); }
__device__ __forceinline__ float fast_rcp(float x) { return __builtin_amdgcn_rcpf(x); }
__device__ __forceinline__ float sigmoidf_(float x) { return fast_rcp(1.f + __builtin_amdgcn_exp2f(-1.4426950408889634f * x)); }

namespace pg8 {
constexpr int BM = 256, BK = 64, HALF = 128, HTB = HALF * BK * 2, STAGE_BYTES = 8 * HTB, NXCD = 8, WGM = 8;
__host__ __device__ __forceinline__ int lds_byte(int r, int c) { const int st = (r >> 4) * 2 + (c >> 5), rr = r & 15, cc = c & 31, ob = rr * 64 + cc * 2; return st * 1024 + (ob ^ (((ob >> 9) & 1) << 5)); }
__host__ __device__ __forceinline__ void stage_rc(int b, int& R, int& C) { const int st = b / 1024, sb = b % 1024, swz = sb ^ (((sb >> 9) & 1) << 5); R = (st >> 1) * 16 + swz / 64; C = (st & 1) * 32 + (swz % 64) / 2; }
__host__ __device__ __forceinline__ int perm32(int rho) { const int n = rho >> 4, i = rho & 15; return 8 * (i >> 2) + 4 * n + (i & 3); }

struct Unit { int pm, pn, pz; };
struct Gemm { const bf16_t* A; const bf16_t* Bt; int K, lda, ldb; long bsA, bsB; };

struct Order {
    int nM, nN, nZ, nwg, G, c, rep;
    __device__ __forceinline__ void init(int nM_, int nN_, int nZ_, int G_, int c_, int rep_) { nM = nM_; nN = nN_; nZ = nZ_; nwg = nM * nN; G = G_; c = c_; rep = rep_; }
    __device__ __forceinline__ bool next(int i, Unit& u) const {
        long L; int pz;
        if (rep == 1) { L = (long)i * G + c; if (L >= (long)nwg * nZ) return false; pz = (int)(L / nwg); L = L % nwg; }
        else { L = (long)(i / rep) * G + c; if (L >= nwg) return false; pz = i % rep; }
        int wgid = (int)L; { const int q = nwg / NXCD, r = nwg % NXCD, xcd = wgid % NXCD, off = wgid / NXCD; wgid = (xcd < r ? xcd * (q + 1) : r * (q + 1) + (xcd - r) * q) + off; }
        const int nig = WGM * nN, gid = wgid / nig, fm = gid * WGM, gsz = (nM - fm) < WGM ? (nM - fm) : WGM;
        u.pm = fm + ((wgid % nig) % gsz); u.pn = (wgid % nig) / gsz; u.pz = pz; return true;
    }
};

typedef f32x4 Acc[2][2][4][2];

template <class Epi, bool ALIGN_EPI, bool SP2>
__device__ __forceinline__ void gemm_phase(LAS unsigned char* lds, const Gemm g, const Order S, const Epi E) {
    int tid_ = threadIdx.x; asm volatile("" : "+v"(tid_));
    const int tid = tid_, wid = __builtin_amdgcn_readfirstlane(tid >> 6), lane = tid & 63, wr = wid >> 2, wc = wid & 3, fr = lane & 15, fq = lane >> 4;
    const int K = g.K, nt = K / BK;
    unsigned voffA[2], voffB[2];
#pragma unroll
    for (int i = 0; i < 2; ++i) { int R, C; stage_rc(tid * 16 + i * 8192, R, C); const int Rb = Epi::PERM ? ((R & ~31) + perm32(R & 31)) : R;
        voffA[i] = (unsigned)(R * g.lda + C) * 2u; voffB[i] = (unsigned)(Rb * g.ldb + C) * 2u; }
    const size_t kstep = (size_t)(BK * 2);
    const size_t hstepA = (size_t)HALF * g.lda * 2, hstepB = (size_t)HALF * g.ldb * 2;
    const size_t tstepA = 2 * hstepA, tstepB = 2 * hstepB;
    const unsigned ldsw = (unsigned)wid * 1024u;
    const int aoff = lds_byte(wr * 64 + fr, fq * 8), boff = lds_byte(wc * 32 + fr, fq * 8);
#define PG8_SA(b, h) (((b) * 2 + (h)) * HTB)
#define PG8_SB(b, h) ((4 + (b) * 2 + (h)) * HTB)
#define PG8_STAGE(bufoff, gbase, voff) do { _Pragma("unroll") for (int _i = 0; _i < 2; ++_i) \
        __builtin_amdgcn_global_load_lds((const unsigned*)((const char*)(gbase) + (voff)[_i]), (LAS unsigned*)(lds + (bufoff) + ldsw + _i * 8192), 16, 0, 0); } while (0)
#define PG8_LDA(dst, b, h) do { _Pragma("unroll") for (int m = 0; m < 4; ++m) _Pragma("unroll") for (int k = 0; k < 2; ++k) dst[m][k] = *(const LAS bf16x8*)(lds + PG8_SA(b, h) + aoff + m * 2048 + k * 1024); } while (0)
#define PG8_LDB(dst, b, h) do { _Pragma("unroll") for (int n = 0; n < 2; ++n) _Pragma("unroll") for (int k = 0; k < 2; ++k) dst[n][k] = *(const LAS bf16x8*)(lds + PG8_SB(b, h) + boff + n * 2048 + k * 1024); } while (0)
#define PG8_MMA(ai, bj, At, Bt) do { __builtin_amdgcn_s_setprio(1); _Pragma("unroll") for (int m = 0; m < 4; ++m) _Pragma("unroll") for (int n = 0; n < 2; ++n) _Pragma("unroll") for (int k = 0; k < 2; ++k) \
        acc[ai][bj][m][n] = __builtin_amdgcn_mfma_f32_16x16x32_bf16(Bt[n][k], At[m][k], acc[ai][bj][m][n], 0, 0, 0); __builtin_amdgcn_s_setprio(0); } while (0)
#define PG8_WAIT_V(n) asm volatile("s_waitcnt vmcnt(" #n ")" ::: "memory")
#define PG8_WAIT_L(n) asm volatile("s_waitcnt lgkmcnt(" #n ")" ::: "memory")
#define PG8_BAR __builtin_amdgcn_s_barrier()
#define PG8_SCHED __builtin_amdgcn_sched_barrier(0)
    Unit cur, nxt; int ui = 0;
    if (!S.next(0, cur)) return;
    Acc acc;
#pragma unroll
    for (int a = 0; a < 2; ++a)
#pragma unroll
        for (int b = 0; b < 2; ++b)
#pragma unroll
            for (int m = 0; m < 4; ++m)
#pragma unroll
                for (int n = 0; n < 2; ++n) acc[a][b][m][n] = (f32x4){0.f, 0.f, 0.f, 0.f};
    bf16x8 At[4][2], B0[2][2], B1[2][2];
    const char* cA = (const char*)g.A + (size_t)cur.pm * tstepA + (size_t)cur.pz * g.bsA * 2; const char* cB = (const char*)g.Bt + (size_t)cur.pn * tstepB + (size_t)cur.pz * g.bsB * 2;
    if constexpr (SP2) {
        PG8_STAGE(PG8_SB(0, 0), cB, voffB); PG8_STAGE(PG8_SB(0, 1), cB + hstepB, voffB); PG8_STAGE(PG8_SA(0, 0), cA, voffA); PG8_STAGE(PG8_SA(0, 1), cA + hstepA, voffA);
        if (wr == 1) PG8_BAR;
        PG8_WAIT_V(2); PG8_BAR;
        PG8_STAGE(PG8_SB(1, 0), cB + kstep, voffB); PG8_STAGE(PG8_SA(1, 0), cA + kstep, voffA); PG8_STAGE(PG8_SB(1, 1), cB + hstepB + kstep, voffB);
        PG8_WAIT_V(6); PG8_BAR;
    } else {
        PG8_STAGE(PG8_SB(0, 0), cB, voffB); PG8_STAGE(PG8_SA(0, 0), cA, voffA); PG8_STAGE(PG8_SB(0, 1), cB + hstepB, voffB); PG8_STAGE(PG8_SA(0, 1), cA + hstepA, voffA);
        if (wr == 1) PG8_BAR;
        PG8_WAIT_V(4); PG8_BAR;
        PG8_STAGE(PG8_SB(1, 0), cB + kstep, voffB); PG8_STAGE(PG8_SA(1, 0), cA + kstep, voffA); PG8_STAGE(PG8_SB(1, 1), cB + hstepB + kstep, voffB);
        PG8_WAIT_V(6); PG8_BAR;
    }
    for (;;) {
        const bool has_next = S.next(ui + 1, nxt);
        const char* nA = has_next ? (const char*)g.A + (size_t)nxt.pm * tstepA + (size_t)nxt.pz * g.bsA * 2 : cA;
        const char* nB = has_next ? (const char*)g.Bt + (size_t)nxt.pn * tstepB + (size_t)nxt.pz * g.bsB * 2 : cB;
#pragma nounroll
        for (int t = 0; t < nt; t += 2) {
            const bool last = (t == nt - 2);
            const char* a1 = cA + (size_t)(t + 1) * kstep;
            const char* a2 = last ? nA : cA + (size_t)(t + 2) * kstep; const char* b2 = last ? nB : cB + (size_t)(t + 2) * kstep;
            const char* a3 = a2 + kstep; const char* b3 = b2 + kstep;
            if constexpr (SP2) {
            PG8_LDB(B0, 0, 0); PG8_LDB(B1, 0, 1); PG8_SCHED; PG8_LDA(At, 0, 0); PG8_STAGE(PG8_SA(1, 1), a1 + hstepA, voffA);
            PG8_WAIT_V(8); PG8_WAIT_L(0); PG8_BAR; PG8_MMA(0, 0, At, B0); PG8_MMA(0, 1, At, B1); PG8_BAR; PG8_SCHED;
            PG8_LDA(At, 0, 1); PG8_STAGE(PG8_SB(0, 0), b2, voffB); PG8_STAGE(PG8_SB(0, 1), b2 + hstepB, voffB); PG8_STAGE(PG8_SA(0, 0), a2, voffA);
            PG8_WAIT_V(8); PG8_WAIT_L(0); PG8_BAR; PG8_MMA(1, 0, At, B0); PG8_MMA(1, 1, At, B1); PG8_BAR; PG8_SCHED;
            PG8_LDB(B0, 1, 0); PG8_LDB(B1, 1, 1); PG8_SCHED; PG8_LDA(At, 1, 0); PG8_STAGE(PG8_SA(0, 1), a2 + hstepA, voffA);
            PG8_WAIT_V(8); PG8_WAIT_L(0); PG8_BAR; PG8_MMA(0, 0, At, B0); PG8_MMA(0, 1, At, B1); PG8_BAR; PG8_SCHED;
            PG8_LDA(At, 1, 1); PG8_STAGE(PG8_SB(1, 0), b3, voffB); PG8_STAGE(PG8_SB(1, 1), b3 + hstepB, voffB); PG8_STAGE(PG8_SA(1, 0), a3, voffA);
            PG8_WAIT_V(8); PG8_WAIT_L(0); PG8_BAR; PG8_MMA(1, 0, At, B0); PG8_MMA(1, 1, At, B1); PG8_BAR; PG8_SCHED;
            } else {
            PG8_LDB(B0, 0, 0); PG8_SCHED; PG8_LDA(At, 0, 0); PG8_STAGE(PG8_SA(1, 1), a1 + hstepA, voffA);
            PG8_WAIT_L(8); PG8_BAR; PG8_WAIT_L(0); PG8_MMA(0, 0, At, B0); PG8_BAR; PG8_SCHED;
            PG8_LDB(B1, 0, 1); PG8_STAGE(PG8_SB(0, 0), b2, voffB);
            PG8_BAR; PG8_WAIT_L(0); PG8_MMA(0, 1, At, B1); PG8_BAR;
            PG8_LDA(At, 0, 1); PG8_STAGE(PG8_SA(0, 0), a2, voffA);
            PG8_BAR; PG8_WAIT_L(0); PG8_MMA(1, 0, At, B0); PG8_BAR; PG8_SCHED;
            PG8_STAGE(PG8_SB(0, 1), b2 + hstepB, voffB);
            PG8_WAIT_V(6); PG8_BAR; PG8_MMA(1, 1, At, B1); PG8_BAR;
            PG8_LDB(B0, 1, 0); PG8_SCHED; PG8_LDA(At, 1, 0); PG8_STAGE(PG8_SA(0, 1), a2 + hstepA, voffA);
            PG8_WAIT_L(8); PG8_BAR; PG8_WAIT_L(0); PG8_MMA(0, 0, At, B0); PG8_BAR; PG8_SCHED;
            PG8_LDB(B1, 1, 1); PG8_STAGE(PG8_SB(1, 0), b3, voffB);
            PG8_BAR; PG8_WAIT_L(0); PG8_MMA(0, 1, At, B1); PG8_BAR;
            PG8_LDA(At, 1, 1); PG8_STAGE(PG8_SA(1, 0), a3, voffA);
            PG8_BAR; PG8_WAIT_L(0); PG8_MMA(1, 0, At, B0); PG8_BAR; PG8_SCHED;
            PG8_STAGE(PG8_SB(1, 1), b3 + hstepB, voffB);
            PG8_WAIT_V(6); PG8_BAR; PG8_MMA(1, 1, At, B1); PG8_BAR;
            }
        }
        if constexpr (ALIGN_EPI) { if (wr == 0) PG8_BAR; }
        E(acc, cur, wr, wc, fr, fq);
        if (!has_next) break;
#pragma unroll
        for (int a = 0; a < 2; ++a)
#pragma unroll
            for (int b = 0; b < 2; ++b)
#pragma unroll
                for (int m = 0; m < 4; ++m)
#pragma unroll
                    for (int n = 0; n < 2; ++n) acc[a][b][m][n] = (f32x4){0.f, 0.f, 0.f, 0.f};
        cur = nxt; cA = nA; cB = nB; ++ui;
        if constexpr (ALIGN_EPI) { if (wr == 1) PG8_BAR; }
    }
    PG8_WAIT_V(0);
    if constexpr (!ALIGN_EPI) { if (wr == 0) PG8_BAR; }
    PG8_BAR;
#undef PG8_SA
#undef PG8_SB
#undef PG8_STAGE
#undef PG8_LDA
#undef PG8_LDB
#undef PG8_MMA
#undef PG8_WAIT_V
#undef PG8_WAIT_L
#undef PG8_BAR
#undef PG8_SCHED
}

struct EpiBf16 {
    static constexpr bool PERM = true;
    bf16_t* O; int ldc; long rbase, zstride; float scale;
    __device__ __forceinline__ void operator()(const Acc& acc, const Unit& u, int wr, int wc, int fr, int fq) const {
        const long row0 = rbase + (long)u.pz * zstride + u.pm * BM + wr * 64 + fr; const int col0 = u.pn * BM + wc * 32 + 8 * fq;
#pragma unroll
        for (int ai = 0; ai < 2; ++ai)
#pragma unroll
            for (int m = 0; m < 4; ++m) { bf16_t* rowp = O + (size_t)(row0 + ai * HALF + m * 16) * ldc + col0;
#pragma unroll
                for (int bj = 0; bj < 2; ++bj) { const f32x4 v0 = acc[ai][bj][m][0] * scale, v1 = acc[ai][bj][m][1] * scale;
                    u32x4 w; w.x = cvt_pk_bf16(v0[0], v0[1]); w.y = cvt_pk_bf16(v0[2], v0[3]); w.z = cvt_pk_bf16(v1[0], v1[1]); w.w = cvt_pk_bf16(v1[2], v1[3]);
                    *(u32x4*)(rowp + bj * HALF) = w; }
                asm volatile("" ::: "memory"); }
    }
};
struct EpiSwiGLU {
    static constexpr bool PERM = true;
    bf16_t* O; int ldc;
    __device__ __forceinline__ void operator()(const Acc& acc, const Unit& u, int wr, int wc, int fr, int fq) const {
        const int row0 = u.pm * BM + wr * 64 + fr, col0 = u.pn * HALF + wc * 32 + 8 * fq;
#pragma unroll
        for (int ai = 0; ai < 2; ++ai)
#pragma unroll
            for (int m = 0; m < 4; ++m) { bf16_t* rowp = O + (size_t)(row0 + ai * HALF + m * 16) * ldc + col0;
                float v[8];
#pragma unroll
                for (int n = 0; n < 2; ++n)
#pragma unroll
                    for (int j = 0; j < 4; ++j) { const float a = acc[ai][0][m][n][j], g = acc[ai][1][m][n][j]; v[n * 4 + j] = a * sigmoidf_(a) * g; }
                u32x4 w; w.x = cvt_pk_bf16(v[0], v[1]); w.y = cvt_pk_bf16(v[2], v[3]); w.z = cvt_pk_bf16(v[4], v[5]); w.w = cvt_pk_bf16(v[6], v[7]);
                *(u32x4*)rowp = w; asm volatile("" ::: "memory"); }
    }
};
template <bool HALFSTEP>
struct EpiResid {
    static constexpr bool PERM = false;
    float* X; const float* coef; float* dout; int fin;
    __device__ __forceinline__ void operator()(const Acc& acc, const Unit& u, int wr, int wc, int fr, int fq) const {
        constexpr float f = HALFSTEP ? 0.5f : 1.f;
        const int b = u.pm / PANB, ip = u.pm % PANB, v = (ip == 0) ? 2 : b;
        if (!(fin && ip == 0)) {
        const int row0 = u.pm * BM + wr * 64 + fr, col0 = u.pn * BM + wc * 32 + 4 * fq;
        const float* cf = coef + (size_t)v * (NMOD * DM) + col0;
        f32x4 cv[2][2];
#pragma unroll
        for (int bj = 0; bj < 2; ++bj)
#pragma unroll
            for (int n = 0; n < 2; ++n) cv[bj][n] = *(const f32x4*)(cf + bj * HALF + n * 16) * f;
        const float* sbase = X + (size_t)row0 * DM + col0;
        float* dbase = fin ? dout + (size_t)(row0 - CTXL * (b + 1)) * DM + col0 : X + (size_t)row0 * DM + col0;
#pragma unroll
        for (int ai = 0; ai < 2; ++ai)
#pragma unroll
            for (int m = 0; m < 4; ++m) { const size_t ro = (size_t)(ai * HALF + m * 16) * DM;
#pragma unroll
                for (int bj = 0; bj < 2; ++bj)
#pragma unroll
                    for (int n = 0; n < 2; ++n) { const f32x4 x = *(const f32x4*)(sbase + ro + bj * HALF + n * 16); *(f32x4*)(dbase + ro + bj * HALF + n * 16) = x + cv[bj][n] * acc[ai][bj][m][n]; }
                asm volatile("" ::: "memory"); }
        }
    }
};
struct EpiChan {
    static constexpr bool PERM = true;
    bf16_t* ABT; bf16_t* ABTC;
    __device__ __forceinline__ void operator()(const Acc& acc, const Unit& u, int wr, int wc, int fr, int fq) const {
        const int b = u.pn / PANB, ip = u.pn % PANB, g = u.pz, cs = u.pm;
        const int tc = wc * 32 + 8 * fq;
        const bool isc = (ip == 0);
        const unsigned ld = isc ? 512u : 16384u;
        bf16_t* base = isc ? ABTC + ((size_t)(b * 1024 + g * 256)) * 512 + cs * 256 + tc : ABT + ((size_t)(b * 1024 + g * 256)) * 16384 + cs * 8192 + (ip - 1) * 256 + tc;
        base += (size_t)(wr * 64 + fr) * ld;
#pragma unroll
        for (int ai = 0; ai < 2; ++ai)
#pragma unroll
            for (int m = 0; m < 4; ++m) { bf16_t* rowp = base + (size_t)((ai * HALF + m * 16) * ld);
#pragma unroll
                for (int bj = 0; bj < 2; ++bj) { const f32x4 v0 = acc[ai][bj][m][0], v1 = acc[ai][bj][m][1];
                    u32x4 w; w.x = cvt_pk_bf16(v0[0], v0[1]); w.y = cvt_pk_bf16(v0[2], v0[3]); w.z = cvt_pk_bf16(v1[0], v1[1]); w.w = cvt_pk_bf16(v1[2], v1[3]);
                    *(u32x4*)(rowp + bj * HALF) = w; }
                asm volatile("" ::: "memory"); }
    }
};
struct EpiSig {
    static constexpr bool PERM = true;
    bf16_t* O; int ldc;
    __device__ __forceinline__ void operator()(const Acc& acc, const Unit& u, int wr, int wc, int fr, int fq) const {
        const int row0 = u.pm * BM + wr * 64 + fr, col0 = u.pn * BM + wc * 32 + 8 * fq;
#pragma unroll
        for (int ai = 0; ai < 2; ++ai)
#pragma unroll
            for (int m = 0; m < 4; ++m) { bf16_t* rowp = O + (size_t)(row0 + ai * HALF + m * 16) * ldc + col0;
#pragma unroll
                for (int bj = 0; bj < 2; ++bj) { float v[8];
#pragma unroll
                    for (int n = 0; n < 2; ++n)
#pragma unroll
                        for (int j = 0; j < 4; ++j) v[n * 4 + j] = sigmoidf_(acc[ai][bj][m][n][j]);
                    u32x4 w; w.x = cvt_pk_bf16(v[0], v[1]); w.y = cvt_pk_bf16(v[2], v[3]); w.z = cvt_pk_bf16(v[4], v[5]); w.w = cvt_pk_bf16(v[6], v[7]);
                    *(u32x4*)(rowp + bj * HALF) = w; }
                asm volatile("" ::: "memory"); }
    }
};
struct EpiMerge {
    static constexpr bool PERM = false;
    const bf16_t* SIG; float* PART; bf16_t* MG;
    __device__ __forceinline__ void operator()(const Acc& acc, const Unit& u, int wr, int wc, int fr, int fq) const {
        const int row0 = u.pm * BM + wr * 64 + fr, col0 = u.pn * BM + wc * 32 + 4 * fq, i = u.pz;
#pragma unroll
        for (int ai = 0; ai < 2; ++ai)
#pragma unroll
            for (int m = 0; m < 4; ++m) { const size_t row = (size_t)(row0 + ai * HALF + m * 16);
#pragma unroll
                for (int bj = 0; bj < 2; ++bj)
#pragma unroll
                    for (int n = 0; n < 2; ++n) { const int c = col0 + bj * HALF + n * 16;
                        const u32x2 sg = *(const u32x2*)(SIG + row * 16384 + (size_t)i * DM + c);
                        f32x4 s; s[0] = bf_lo(sg.x); s[1] = bf_hi(sg.x); s[2] = bf_lo(sg.y); s[3] = bf_hi(sg.y);
                        f32x4 v = s * acc[ai][bj][m][n];
                        float* pp = PART + row * DM + c;
                        if (i > 0) v = v + *(const f32x4*)pp;
                        if (i < 3) *(f32x4*)pp = v;
                        else { u32x2 w; w.x = cvt_pk_bf16(v[0], v[1]); w.y = cvt_pk_bf16(v[2], v[3]); *(u32x2*)(MG + row * DM + c) = w; } }
                asm volatile("" ::: "memory"); }
    }
};
}

namespace att {
constexpr float THR = 8.f;
#define SBAR() __builtin_amdgcn_sched_barrier(0)
__device__ __forceinline__ int crow(int r, int hi) { return (r & 3) + 8 * (r >> 2) + 4 * hi; }
template <int DQK> __device__ __forceinline__ int kswz(int row, int colB) {
    if (DQK == 128) return row * 256 + (colB ^ ((row & 7) << 4));
    else return row * 128 + (colB ^ (((row >> 1) & 7) << 4));
}
template <int DQK, bool MASKED>
__device__ __forceinline__ void partialSM(f32x16& p0, f32x16& p1, float& m_reg, float& mn, float& alpha, bool domask, int dk, int kp0, int hi) {
    constexpr float SCALE = DQK == 128 ? 0.08838834764831845f : 0.125f;
    constexpr float C = SCALE * 1.4426950408889634f;
    if (MASKED && domask) {
#pragma unroll
        for (int r = 0; r < 16; ++r) { const int kk = crow(r, hi); const int d0 = dk + kk, k0 = kp0 + kk, d1 = d0 + 32, k1 = k0 + 32;
            const bool ok0 = (d0 >= -128) & (d0 <= 128) & (k0 >= 0) & (k0 < SEQ), ok1 = (d1 >= -128) & (d1 <= 128) & (k1 >= 0) & (k1 < SEQ);
            p0[r] = ok0 ? p0[r] : -1e30f; p1[r] = ok1 ? p1[r] : -1e30f; }
    }
    float pmax = p0[0];
#pragma unroll
    for (int r = 1; r < 16; ++r) pmax = fmaxf(pmax, p0[r]);
#pragma unroll
    for (int r = 0; r < 16; ++r) pmax = fmaxf(pmax, p1[r]);
    { auto rr = __builtin_amdgcn_permlane32_swap(__float_as_uint(pmax), __float_as_uint(pmax), false, false);
      pmax = fmaxf(__uint_as_float(rr[0]), __uint_as_float(rr[1])); }
    if (__builtin_expect(__all(pmax - m_reg <= THR / SCALE), 1)) { mn = m_reg; alpha = 1.f; }
    else { mn = fmaxf(m_reg, pmax); alpha = __builtin_amdgcn_exp2f((m_reg - mn) * C); m_reg = mn; }
    const float mnC = -mn * C;
#pragma unroll
    for (int r = 0; r < 16; ++r) p0[r] = fmaf(p0[r], C, mnC);
#pragma unroll
    for (int r = 0; r < 16; ++r) p1[r] = fmaf(p1[r], C, mnC);
#pragma unroll
    for (int r = 0; r < 16; ++r) p0[r] = __builtin_amdgcn_exp2f(p0[r]);
}
__device__ __forceinline__ void finishSM(f32x16& p0, f32x16& p1, float alpha, float& l_reg, bf16x8& pa0, bf16x8& pa1, bf16x8& pa2, bf16x8& pa3) {
#pragma unroll
    for (int r = 0; r < 16; ++r) p1[r] = __builtin_amdgcn_exp2f(p1[r]);
    float ps = 0;
#pragma unroll
    for (int r = 0; r < 16; ++r) ps += p0[r];
#pragma unroll
    for (int r = 0; r < 16; ++r) ps += p1[r];
    { auto rr = __builtin_amdgcn_permlane32_swap(__float_as_uint(ps), __float_as_uint(ps), false, false);
      ps = __uint_as_float(rr[0]) + __uint_as_float(rr[1]); }
    l_reg = l_reg * alpha + ps;
#define PK4(P, BASE, OUT) do { unsigned a0 = cvt_pk_bf16(P[BASE + 0], P[BASE + 1]), a1 = cvt_pk_bf16(P[BASE + 2], P[BASE + 3]);   \
    unsigned b0 = cvt_pk_bf16(P[BASE + 4], P[BASE + 5]), b1 = cvt_pk_bf16(P[BASE + 6], P[BASE + 7]);                              \
    auto r0 = __builtin_amdgcn_permlane32_swap(a0, b0, false, false); auto r1 = __builtin_amdgcn_permlane32_swap(a1, b1, false, false); \
    u32x4 w = {r0[0], r1[0], r0[1], r1[1]}; OUT = *reinterpret_cast<bf16x8*>(&w); } while (0)
    PK4(p0, 0, pa0); PK4(p0, 8, pa1); PK4(p1, 0, pa2); PK4(p1, 8, pa3);
#undef PK4
}
template <int DQK>
__device__ __forceinline__ void qkt(f32x16& p0, f32x16& p1, const LAS char* Ks, const bf16x8* qr, int r32, int hi) {
    p0 = f32x16{}; p1 = f32x16{};
#pragma unroll
    for (int d0 = 0; d0 < DQK / 16; ++d0) { const int cb = (d0 * 16 + hi * 8) * 2;
        const bf16x8 b0 = *reinterpret_cast<const LAS bf16x8*>(Ks + kswz<DQK>(r32, cb));
        const bf16x8 b1 = *reinterpret_cast<const LAS bf16x8*>(Ks + kswz<DQK>(32 + r32, cb));
        p0 = __builtin_amdgcn_mfma_f32_32x32x16_bf16(b0, qr[d0], p0, 0, 0, 0);
        p1 = __builtin_amdgcn_mfma_f32_32x32x16_bf16(b1, qr[d0], p1, 0, 0, 0); }
}
__device__ __forceinline__ int v_st(int k, int c) { const int kk = (k & ~0xC) | ((k & 4) << 1) | ((k & 8) >> 1); return ((kk >> 3) * 4 + (c >> 5)) * 512 + ((kk & 7) * 32 + (c & 31)) * 2; }
__device__ __forceinline__ int v_rd_base(int lane) { return ((lane & 3) << 3) | (((lane >> 2) & 3) << 6) | (((lane >> 4) & 1) << 5) | (((lane >> 5) & 1) << 8); }
constexpr int v_rd_off(int d0, int ks, int half) { return d0 * 512 + ks * 4096 + half * 2048; }
template <int OFF> __device__ __forceinline__ s16x4 tr_read(int vb) {
    s16x4 r; asm volatile("ds_read_b64_tr_b16 %0, %1 offset:%2" : "=&v"(r) : "v"(vb), "i"(OFF) : "memory"); return r;
}
template <int D0> __device__ __forceinline__ void pv_one(f32x16& od, int vb, bf16x8 pa0, bf16x8 pa1, bf16x8 pa2, bf16x8 pa3) {
    const s16x4 l0 = tr_read<v_rd_off(D0, 0, 0)>(vb), h0 = tr_read<v_rd_off(D0, 0, 1)>(vb), l1 = tr_read<v_rd_off(D0, 1, 0)>(vb), h1 = tr_read<v_rd_off(D0, 1, 1)>(vb);
    const s16x4 l2 = tr_read<v_rd_off(D0, 2, 0)>(vb), h2 = tr_read<v_rd_off(D0, 2, 1)>(vb), l3 = tr_read<v_rd_off(D0, 3, 0)>(vb), h3 = tr_read<v_rd_off(D0, 3, 1)>(vb);
    asm volatile("s_waitcnt lgkmcnt(0)" ::: "memory"); SBAR();
#define PK(L, H) (bf16x8){L[0], L[1], L[2], L[3], H[0], H[1], H[2], H[3]}
    od = __builtin_amdgcn_mfma_f32_32x32x16_bf16(pa0, PK(l0, h0), od, 0, 0, 0);
    od = __builtin_amdgcn_mfma_f32_32x32x16_bf16(pa1, PK(l1, h1), od, 0, 0, 0);
    od = __builtin_amdgcn_mfma_f32_32x32x16_bf16(pa2, PK(l2, h2), od, 0, 0, 0);
    od = __builtin_amdgcn_mfma_f32_32x32x16_bf16(pa3, PK(l3, h3), od, 0, 0, 0);
#undef PK
}
__device__ __forceinline__ void pv_d0(f32x16* o, int vb, bf16x8 pa0, bf16x8 pa1, bf16x8 pa2, bf16x8 pa3) {
    pv_one<0>(o[0], vb, pa0, pa1, pa2, pa3); pv_one<1>(o[1], vb, pa0, pa1, pa2, pa3); pv_one<2>(o[2], vb, pa0, pa1, pa2, pa3); pv_one<3>(o[3], vb, pa0, pa1, pa2, pa3);
}

template <int DQK, bool MASKED, int LDQ, int LDK, int LDV>
__device__ __forceinline__ void attn_unit(const bf16_t* __restrict__ Qb, const bf16_t* __restrict__ Kb, const bf16_t* __restrict__ Vb,
                                          int NT, int nctx, int loc0, int qpos0, float m_init, float l_init, LAS char* lds, f32x16 (&o)[4]) {
    constexpr int SHM_V = 64 * 128 * 2, SHM_K = 64 * DQK * 2, NQ = DQK / 16;
    int tid_ = threadIdx.x; asm volatile("" : "+v"(tid_));
    const int tid = tid_, wid = __builtin_amdgcn_readfirstlane(tid >> 6), lane = tid & 63, r32 = lane & 31, hi = lane >> 5;
    LAS char* V_lds = lds; LAS char* K_lds = lds + 2 * SHM_V;
    LAS float* ws = (LAS float*)(lds + 2 * SHM_V + 2 * SHM_K) + wid * 64; LAS float* li_l = ws; LAS float* al_l = ws + 32;
    float m_reg = m_init, l_reg = l_init;
#pragma unroll
    for (int d = 0; d < 4; ++d) o[d] = f32x16{};
    bf16x8 qr[NQ];
    const bf16_t* Qw = Qb + (unsigned)((wid * 32 + r32) * LDQ + hi * 8);
#pragma unroll
    for (int d0 = 0; d0 < NQ; ++d0) qr[d0] = *reinterpret_cast<const bf16x8*>(Qw + d0 * 16);
    const int sr = tid >> 4, sc = (tid & 15) * 8, vst0 = v_st(sr, sc), vst1 = v_st(32 + sr, sc);
    const int kr = (DQK == 128) ? sr : (tid >> 3), kc = (DQK == 128) ? sc : (tid & 7) * 8;
    const int kst0 = kswz<DQK>(kr, kc * 2), kst1 = kswz<DQK>(32 + kr, kc * 2);
    const int vb0 = (int)(unsigned)(uintptr_t)V_lds + v_rd_base(lane);
    const int qrel = qpos0 + wid * 32 + r32;
    const unsigned vo = (unsigned)(sr * LDV + sc) * 2u, ko = (unsigned)(kr * LDK + kc) * 2u;
    struct Slot { bf16x8 vs0, vs1, ks0, ks1; } s0, s1;
#define TROW(j) ((!MASKED || (j) < nctx) ? 64 * (j) : (CTXL + min(max(loc0 + 64 * ((j) - nctx), 0), SEQ - 64)))
#define SLOAD(S, j) do { const int rb_ = TROW(j); const char* vp_ = (const char*)Vb + (size_t)rb_ * (LDV * 2); const char* kp_ = (const char*)Kb + (size_t)rb_ * (LDK * 2); \
    S.vs0 = *reinterpret_cast<const bf16x8*>(vp_ + vo); S.vs1 = *reinterpret_cast<const bf16x8*>(vp_ + 32 * LDV * 2 + vo); \
    S.ks0 = *reinterpret_cast<const bf16x8*>(kp_ + ko); if (DQK == 128) S.ks1 = *reinterpret_cast<const bf16x8*>(kp_ + 32 * LDK * 2 + ko); } while (0)
#define SWRITE(b, S) do { *reinterpret_cast<LAS bf16x8*>(V_lds + (b) * SHM_V + vst0) = S.vs0; *reinterpret_cast<LAS bf16x8*>(V_lds + (b) * SHM_V + vst1) = S.vs1; \
    *reinterpret_cast<LAS bf16x8*>(K_lds + (b) * SHM_K + kst0) = S.ks0; if (DQK == 128) *reinterpret_cast<LAS bf16x8*>(K_lds + (b) * SHM_K + kst1) = S.ks1; } while (0)
#define SWAIT() do { if (DQK == 128) asm volatile("s_waitcnt vmcnt(4)" ::: "memory"); else asm volatile("s_waitcnt vmcnt(3)" ::: "memory"); } while (0)
#define RESC(a) do { if (__any((a) < 1.f)) { if (hi == 0) al_l[r32] = (a); asm volatile("s_waitcnt lgkmcnt(0)" ::: "memory"); \
    _Pragma("unroll") for (int d = 0; d < 4; ++d) _Pragma("unroll") for (int r = 0; r < 16; ++r) o[d][r] *= al_l[crow(r, hi)]; } } while (0)
#define PSM(P0, P1, MN, AL, j) partialSM<DQK, MASKED>(P0, P1, m_reg, MN, AL, MASKED && (j) >= nctx, loc0 + 64 * ((j) - nctx) - qrel, loc0 + 64 * ((j) - nctx), hi)
    f32x16 pA0, pA1, pB0, pB1; float mnA, mnB, alA, alB; bf16x8 pa0, pa1, pa2, pa3;
    SLOAD(s0, 0); asm volatile("s_waitcnt vmcnt(0)" ::: "memory"); SWRITE(0, s0); __syncthreads();
    qkt<DQK>(pA0, pA1, K_lds, qr, r32, hi); PSM(pA0, pA1, mnA, alA, 0);
    SLOAD(s1, 1); if (2 < NT) SLOAD(s0, 2);
    SWAIT(); SWRITE(1, s1); __syncthreads();
    for (int j = 1; j + 1 < NT; j += 2) {
        SBAR(); qkt<DQK>(pB0, pB1, K_lds + SHM_K, qr, r32, hi);
        finishSM(pA0, pA1, alA, l_reg, pa0, pa1, pa2, pa3); SBAR();
        SLOAD(s1, j + 2); SBAR();
        pv_d0(o, vb0, pa0, pa1, pa2, pa3); PSM(pB0, pB1, mnB, alB, j);
        __syncthreads(); SWAIT(); SWRITE(0, s0);
        RESC(alB); __syncthreads();
        SBAR(); qkt<DQK>(pA0, pA1, K_lds, qr, r32, hi);
        finishSM(pB0, pB1, alB, l_reg, pa0, pa1, pa2, pa3); SBAR();
        if (j + 3 < NT) SLOAD(s0, j + 3);
        SBAR();
        pv_d0(o, vb0 + SHM_V, pa0, pa1, pa2, pa3); PSM(pA0, pA1, mnA, alA, j + 1);
        __syncthreads(); SWAIT(); SWRITE(1, s1);
        RESC(alA); __syncthreads();
    }
    SBAR(); qkt<DQK>(pB0, pB1, K_lds + SHM_K, qr, r32, hi);
    finishSM(pA0, pA1, alA, l_reg, pa0, pa1, pa2, pa3); SBAR();
    pv_d0(o, vb0, pa0, pa1, pa2, pa3); PSM(pB0, pB1, mnB, alB, NT - 1);
    __syncthreads(); RESC(alB);
    finishSM(pB0, pB1, alB, l_reg, pa0, pa1, pa2, pa3); SBAR();
    pv_d0(o, vb0 + SHM_V, pa0, pa1, pa2, pa3);
    if (hi == 0) li_l[r32] = l_reg;
    asm volatile("s_waitcnt lgkmcnt(0)" ::: "memory");
#pragma unroll
    for (int r = 0; r < 16; ++r) { const float rl = __builtin_amdgcn_rcpf(li_l[crow(r, hi)]);
#pragma unroll
        for (int d = 0; d < 4; ++d) o[d][r] *= rl; }
    __syncthreads();
#undef TROW
#undef SLOAD
#undef SWRITE
#undef SWAIT
#undef RESC
#undef PSM
}
}

#define XB_TMO      128
#define XB_XCNT(j)  (256  + 64 * (j))
#define XB_XSUB(j)  (1280 + 64 * (j))
#define XB_XGEN(j)  (2304 + 64 * (j))
#define XB_TOP      3328
#define XB_TOPGEN   3392
#define XCD_BAR_WORDS 3456
#define XB_SPIN_CAP (1u << 18)
__device__ __forceinline__ unsigned xb_ld(unsigned* p)              { return __hip_atomic_load(p, __ATOMIC_RELAXED, __HIP_MEMORY_SCOPE_AGENT); }
__device__ __forceinline__ unsigned xb_add(unsigned* p, unsigned v) { return __hip_atomic_fetch_add(p, v, __ATOMIC_RELAXED, __HIP_MEMORY_SCOPE_AGENT); }
__device__ __forceinline__ unsigned xb_xcc_id() { return (unsigned)__builtin_amdgcn_s_getreg((3 << 11) | 20) & 0xFu; }
#define XB_SPIN(cond, bar) do { unsigned _sp = 0; while (cond) { __builtin_amdgcn_s_sleep(1); \
    if ((++_sp & 255u) == 0u) { if (xb_ld(&(bar)[XB_TMO])) break; if (_sp > XB_SPIN_CAP) { atomicAdd(&(bar)[XB_TMO], 1u); break; } } } } while (0)
struct XcdBarrier { unsigned* bar; unsigned x; volatile LAS unsigned* st; };
__device__ __forceinline__ XcdBarrier xcd_barrier_post(unsigned* bar, volatile LAS unsigned* st) {
    XcdBarrier b; b.bar = bar; b.x = xb_xcc_id(); b.st = st;
    if (threadIdx.x == 0) (void)xb_add(&bar[XB_XCNT(b.x)], 1u);
    return b;
}
__device__ __forceinline__ void xcd_barrier_complete(unsigned* bar, unsigned x, unsigned& nloc, unsigned& nx) {
    const unsigned G = gridDim.x * gridDim.y * gridDim.z;
    unsigned sum, cnt, mine, sp = 0u;
    for (;;) {
        sum = 0u; cnt = 0u; mine = 0u;
#pragma unroll
        for (unsigned j = 0; j < 16; ++j) { const unsigned c = xb_ld(&bar[XB_XCNT(j)]); sum += c; cnt += (c > 0u) ? 1u : 0u; mine = (j == x) ? c : mine; }
        if (sum == G) break;
        __builtin_amdgcn_s_sleep(1);
        if ((++sp & 255u) == 0u) { if (xb_ld(&bar[XB_TMO])) break; if (sp > XB_SPIN_CAP) { atomicAdd(&bar[XB_TMO], 1u); break; } }
    }
    nloc = mine > 0u ? mine : 1u; nx = cnt > 0u ? cnt : 1u;
}
__device__ __forceinline__ void xcd_barrier(const XcdBarrier& b) {
    asm volatile("s_waitcnt vmcnt(0)" ::: "memory");
    __syncthreads();
    if (threadIdx.x == 0) {
        unsigned* bar = b.bar;
        __builtin_amdgcn_s_waitcnt(0);
        unsigned nloc = b.st[0], nx = b.st[1];
        if (nloc == 0u) { xcd_barrier_complete(bar, b.x, nloc, nx); b.st[0] = nloc; b.st[1] = nx; }
        const unsigned old = xb_add(&bar[XB_XSUB(b.x)], 1u);
        const unsigned gen = old / nloc;
        if (old + 1u == (gen + 1u) * nloc) {
            __builtin_amdgcn_fence(__ATOMIC_RELEASE, "agent");
            asm volatile("s_waitcnt vmcnt(0)" ::: "memory");
            const unsigned og = xb_add(&bar[XB_TOP], 1u);
            const unsigned tg = og / nx;
            if (og + 1u == (tg + 1u) * nx) xb_add(&bar[XB_TOPGEN], 1u);
            else XB_SPIN(xb_ld(&bar[XB_TOPGEN]) == tg, bar);
            __builtin_amdgcn_fence(__ATOMIC_ACQUIRE, "agent");
            xb_add(&bar[XB_XGEN(b.x)], 1u);
            asm volatile("s_waitcnt vmcnt(0)" ::: "memory");
        } else {
            XB_SPIN(xb_ld(&bar[XB_XGEN(b.x)]) == gen, bar);
            __builtin_amdgcn_fence(__ATOMIC_ACQUIRE, "agent");
            asm volatile("s_waitcnt vmcnt(0)" ::: "memory");
        }
    }
    __syncthreads();
}

struct Args { const float* in[22]; float* out; unsigned char* ws; int ph_lo, ph_hi; };
__device__ __forceinline__ const float* inp(LAS unsigned char* lds, int k) {
    volatile LAS unsigned* p = (volatile LAS unsigned*)(lds + PTR_OFF) + 2 * k;
    const unsigned lo = __builtin_amdgcn_readfirstlane(p[0]), hi = __builtin_amdgcn_readfirstlane(p[1]);
    return (const float*)(const GAS float*)(((unsigned long long)hi << 32) | lo);
}

__device__ __forceinline__ float wave_sum(float v) {
#pragma unroll
    for (int o = 1; o < 64; o <<= 1) v += __shfl_xor(v, o);
    return v;
}
__device__ __forceinline__ void tr_item(const float* __restrict__ W, int N, bf16_t* __restrict__ WT, int ldd, int k0, int n0, int drow0, int dcol0, LAS unsigned* scr, int lane) {
    const float* src = W + (size_t)k0 * N + n0 + lane;
#pragma unroll 8
    for (int kk = 0; kk < 64; ++kk) { const float a = src[(size_t)(2 * kk) * N], b = src[(size_t)(2 * kk + 1) * N]; scr[lane * 65 + kk] = cvt_pk_bf16(a, b); }
    LDS_WAIT(); asm volatile("" ::: "memory");
    const int q = lane & 15;
#pragma unroll 4
    for (int i = 0; i < 16; ++i) { const int n = 4 * i + (lane >> 4); const LAS unsigned* s = scr + n * 65 + 4 * q;
        u32x4 o; o.x = s[0]; o.y = s[1]; o.z = s[2]; o.w = s[3];
        *(u32x4*)(WT + (size_t)(drow0 + n) * ldd + dcol0 + 8 * q) = o; }
    LDS_WAIT(); asm volatile("" ::: "memory");
}

__device__ __forceinline__ void prologue_a(unsigned char* ws, LAS unsigned char* lds, int gw, int NGW, int wave, int lane) {
    LAS unsigned* scr = (LAS unsigned*)(lds + wave * 16640);
    constexpr int I13 = 32 * 160, I2 = 40 * 64, IIN = 32 * 140, IB = 8 * 64, IG = 2 * 256, IO = 32 * 64;
    constexpr int IL = 2 * I13 + 2 * I2 + IIN + 4 * IB + IG + IO;
    const float* p8 = inp(lds, 8); const float* p9 = inp(lds, 9); const float* p10 = inp(lds, 10); const float* p19 = inp(lds, 19); const float* p20 = inp(lds, 20); const float* p21 = inp(lds, 21);
    for (int it = gw; it < DEPTH * IL; it += NGW) {
        const int l = it / IL; int r = it % IL; unsigned char* wl = ws + WS_W + (size_t)l * WL_SIZE;
        if (r < 2 * I13) { const int k = r / I13; r %= I13; const int kb = r / 160, nb = r % 160, n0 = nb * 64;
            const int drow0 = n0 < DFF ? 256 * (n0 / 128) + (n0 % 128) : 256 * ((n0 - DFF) / 128) + 128 + ((n0 - DFF) % 128);
            tr_item(p8 + (size_t)(l * 2 + k) * DM * 2 * DFF, 2 * DFF, (bf16_t*)(wl + WL_W13) + (size_t)k * 2 * DFF * DM, DM, kb * 128, n0, drow0, kb * 128, scr, lane); continue; }
        r -= 2 * I13;
        if (r < 2 * I2) { const int k = r / I2; r %= I2; const int kb = r / 64, nb = r % 64;
            tr_item(p9 + (size_t)(l * 2 + k) * DFF * DM, DM, (bf16_t*)(wl + WL_W2) + (size_t)k * DM * DFF, DFF, kb * 128, nb * 64, nb * 64, kb * 128, scr, lane); continue; }
        r -= 2 * I2;
        if (r < IIN) { const int kb = r / 140, nb = r % 140;
            tr_item(p10 + (size_t)l * DM * NIN, NIN, (bf16_t*)(wl + WL_WIN), DM, kb * 128, nb * 64, nb * 64, kb * 128, scr, lane); continue; }
        r -= IIN;
        if (r < 4 * IB) { const int i = r / IB; r %= IB; const int kb = r / 64, nb = r % 64;
            tr_item(p19 + (size_t)(l * 4 + i) * 1024 * DM, DM, (bf16_t*)(wl + WL_WB), DM, kb * 128, nb * 64, nb * 64, i * 1024 + kb * 128, scr, lane); continue; }
        r -= 4 * IB;
        if (r < IG) { const int kb = r / 256, nb = r % 256;
            tr_item(p20 + (size_t)l * 256 * 16384, 16384, (bf16_t*)(wl + WL_GATE), 256, kb * 128, nb * 64, nb * 64, kb * 128, scr, lane); continue; }
        r -= IG;
        { const int kb = r / 64, nb = r % 64;
            tr_item(p21 + (size_t)l * DM * DM, DM, (bf16_t*)(wl + WL_WO), DM, kb * 128, nb * 64, nb * 64, kb * 128, scr, lane); }
    }
    const long gt = (long)gw * 64 + lane, NGT = (long)NGW * 64;
    { bf16_t* cs = (bf16_t*)(ws + WS_CS);
      for (long idx = gt; idx < (long)SEQ * 2048; idx += NGT) { const int k = (int)(idx >> 11), c8 = (int)(idx & 2047), tp = c8 * 8, part = tp >> 13, t0 = tp & 8191; float v[8];
#pragma unroll
          for (int e = 0; e < 8; ++e) { const float x = (float)((k * (t0 + e)) & 8191) * (1.f / 8192.f); v[e] = part ? __builtin_amdgcn_sinf(x) : __builtin_amdgcn_cosf(x); }
          u32x4 w; w.x = cvt_pk_bf16(v[0], v[1]); w.y = cvt_pk_bf16(v[2], v[3]); w.z = cvt_pk_bf16(v[4], v[5]); w.w = cvt_pk_bf16(v[6], v[7]);
          *(u32x4*)(cs + idx * 8) = w; } }
    { bf16_t* ct = (bf16_t*)(ws + WS_CSCT); bf16_t* cx = (bf16_t*)(ws + WS_CSCTX);
      for (long idx = gt; idx < 512 * 256; idx += NGT) { const int m = (int)(idx >> 8), c = (int)(idx & 255); const float x = (float)(((m & 255) * c) & 255) * (1.f / 256.f);
          const float v = (m < 256) ? __builtin_amdgcn_cosf(x) : -__builtin_amdgcn_sinf(x); ct[idx] = (bf16_t)(cvt_pk_bf16(v, 0.f) & 0xffffu); }
      for (long idx = gt; idx < 256 * 512; idx += NGT) { const int k = (int)(idx >> 9), tp = (int)(idx & 511); const float x = (float)((k * (tp & 255)) & 255) * (1.f / 256.f);
          const float v = (tp < 256) ? __builtin_amdgcn_cosf(x) : __builtin_amdgcn_sinf(x); cx[idx] = (bf16_t)(cvt_pk_bf16(v, 0.f) & 0xffffu); } }
    { float* rp = (float*)(ws + WS_ROPE);
      for (long idx = gt; idx < 128 * 32; idx += NGT) { const int pos = (int)(idx >> 5), i = (int)(idx & 31); const float inv = exp2f(-(float)(2 * i) * (1.f / 64.f) * 13.287712379549449f);
          float rev = (float)pos * inv * 0.15915494309189535f; rev -= floorf(rev); rp[idx] = __builtin_amdgcn_cosf(rev); rp[4096 + idx] = __builtin_amdgcn_sinf(rev); }
      for (long idx = gt; idx < 128 * 16; idx += NGT) { const int pos = (int)(idx >> 4), i = (int)(idx & 15); const float inv = exp2f(-(float)(2 * i) * (1.f / 32.f) * 13.287712379549449f);
          float rev = (float)pos * inv * 0.15915494309189535f; rev -= floorf(rev); rp[8192 + idx] = __builtin_amdgcn_cosf(rev); rp[8192 + 2048 + idx] = __builtin_amdgcn_sinf(rev); } }
    { float* xs = (float*)(ws + WS_XS); const float* pctx = inp(lds, 2); const float* px = inp(lds, 0);
      for (int r = gw; r < T; r += NGW) { const int b = r / TB, i = r % TB; const float* src = (i < CTXL) ? pctx + (size_t)(b * CTXL + i) * DM : px + (size_t)(b * SEQ + i - CTXL) * DM;
          const f32x4* s4 = (const f32x4*)src + lane; f32x4* d4 = (f32x4*)(xs + (size_t)r * DM) + lane;
#pragma unroll
          for (int j = 0; j < 16; ++j) d4[64 * j] = s4[64 * j]; } }
    { float* t1 = (float*)(ws + WS_T1P); const float* pc = inp(lds, 1); const float* pcc = inp(lds, 3); const float* pdn = inp(lds, 5);
      for (int it = gw; it < DEPTH * 64; it += NGW) { const int l = it >> 6, ch = it & 63; f32x4 acc0 = {0, 0, 0, 0}, acc1 = acc0, acc2 = acc0;
          const float* dn = pdn + ((size_t)l * DM + ch * 64) * 256 + 4 * lane;
          for (int d = 0; d < 64; ++d) { const int dd = ch * 64 + d; const f32x4 row = *(const f32x4*)(dn + (size_t)d * 256);
              const float c0 = pc[dd], c1 = pc[DM + dd], c2 = pcc[dd];
              acc0 += row * (c0 / (1.f + __expf(-c0))); acc1 += row * (c1 / (1.f + __expf(-c1))); acc2 += row * (c2 / (1.f + __expf(-c2))); }
          float* o = t1 + ((size_t)(l * 64 + ch) * 3) * 256 + 4 * lane; *(f32x4*)o = acc0; *(f32x4*)(o + 256) = acc1; *(f32x4*)(o + 512) = acc2; } }
    if (gw == 0) { float* lm = (float*)(ws + WS_LAM); const float* pdl = inp(lds, 17);
        for (int l = 0; l < DEPTH; ++l) { const float* dl = pdl + l * 256; const float s1 = wave_sum(dl[lane] * dl[64 + lane]), s2 = wave_sum(dl[128 + lane] * dl[192 + lane]);
            const float li = 0.8f - 0.6f * expf(-0.3f * (float)l); if (lane == 0) { lm[l] = expf(s1) - expf(s2) + li; lm[4 + l] = 1.f - li; } } }
}
__device__ __forceinline__ void prologue_b(unsigned char* ws, LAS unsigned char* lds, int gw, int NGW, int wave, int lane) {
    LAS float* tl = (LAS float*)(lds + wave * 4096);
    const float* t1 = (const float*)(ws + WS_T1P); float* mod = (float*)(ws + WS_MOD); const float* pb7 = inp(lds, 7); const float* pup = inp(lds, 6);
    for (int it = gw; it < DEPTH * 144; it += NGW) { const int l = it / 144, n0 = (it % 144) * 256 + 4 * lane;
        f32x4 t0 = {0, 0, 0, 0}, t1v = t0, t2 = t0;
        for (int ch = 0; ch < 64; ++ch) { const float* p = t1 + ((size_t)(l * 64 + ch) * 3) * 256 + 4 * lane; t0 += *(const f32x4*)p; t1v += *(const f32x4*)(p + 256); t2 += *(const f32x4*)(p + 512); }
        *(LAS f32x4*)(tl + 4 * lane) = t0; *(LAS f32x4*)(tl + 256 + 4 * lane) = t1v; *(LAS f32x4*)(tl + 512 + 4 * lane) = t2;
        LDS_WAIT(); asm volatile("" ::: "memory");
        const f32x4 bb = *(const f32x4*)(pb7 + (size_t)l * NMOD * DM + n0); f32x4 acc0 = bb, acc1 = bb, acc2 = bb;
        const float* up = pup + (size_t)l * 256 * NMOD * DM + n0;
#pragma unroll 4
        for (int j = 0; j < 256; ++j) { const f32x4 row = *(const f32x4*)(up + (size_t)j * NMOD * DM); acc0 += row * tl[j]; acc1 += row * tl[256 + j]; acc2 += row * tl[512 + j]; }
        float* o = mod + (size_t)(l * 3) * NMOD * DM + n0; *(f32x4*)o = acc0; *(f32x4*)(o + NMOD * DM) = acc1; *(f32x4*)(o + 2 * NMOD * DM) = acc2;
        LDS_WAIT(); asm volatile("" ::: "memory"); }
}
__device__ __forceinline__ void norm_phase(unsigned char* ws, LAS unsigned char* lds, int l, int k, int gw, int NGW, int tid, int lane) {
    asm volatile("" : "+v"(lane), "+v"(tid));
    LAS float* gp = (LAS float*)lds; LAS float* sh = gp + 3 * DM;
    const float* mod = (const float*)(ws + WS_MOD) + (size_t)(l * 3) * NMOD * DM; const float* g = inp(lds, 4) + (size_t)(l * 3 + k) * DM;
    for (int i = tid; i < 3 * DM; i += NTHREADS) { const int v = i / DM, c = i % DM; gp[i] = g[c] * (1.f + mod[(size_t)v * NMOD * DM + (3 * k + 1) * DM + c]); sh[i] = mod[(size_t)v * NMOD * DM + (3 * k) * DM + c]; }
    __syncthreads();
    const float* xs = (const float*)(ws + WS_XS); bf16_t* H = (bf16_t*)(ws + WS_H);
    for (int r = gw; r < T; r += NGW) { const int b = r / TB, i = r % TB, v = (i < CTXL) ? 2 : b;
        const f32x4* xr = (const f32x4*)(xs + (size_t)r * DM) + lane; f32x4 x[16]; float s = 0.f;
#pragma unroll
        for (int j = 0; j < 16; ++j) { x[j] = xr[64 * j]; s += (x[j][0] * x[j][0] + x[j][1] * x[j][1]) + (x[j][2] * x[j][2] + x[j][3] * x[j][3]); }
        const float rstd = 1.f / sqrtf(wave_sum(s) * (1.f / DM) + EPS);
        u32x2* o = (u32x2*)(H + (size_t)r * DM) + lane;
#pragma unroll
        for (int j = 0; j < 16; ++j) { const f32x4 gg = *(const LAS f32x4*)(gp + v * DM + 4 * lane + 256 * j), ss = *(const LAS f32x4*)(sh + v * DM + 4 * lane + 256 * j);
            const f32x4 y = x[j] * rstd * gg + ss; u32x2 w; w.x = cvt_pk_bf16(y[0], y[1]); w.y = cvt_pk_bf16(y[2], y[3]); o[64 * j] = w; } }
    __syncthreads();
}
__device__ __forceinline__ void ld16(const bf16_t* p, float (&x)[16]) { const u32x4 a = *(const u32x4*)p, b = *(const u32x4*)(p + 8);
    x[0] = bf_lo(a.x); x[1] = bf_hi(a.x); x[2] = bf_lo(a.y); x[3] = bf_hi(a.y); x[4] = bf_lo(a.z); x[5] = bf_hi(a.z); x[6] = bf_lo(a.w); x[7] = bf_hi(a.w);
    x[8] = bf_lo(b.x); x[9] = bf_hi(b.x); x[10] = bf_lo(b.y); x[11] = bf_hi(b.y); x[12] = bf_lo(b.z); x[13] = bf_hi(b.z); x[14] = bf_lo(b.w); x[15] = bf_hi(b.w); }
__device__ __forceinline__ void st16(bf16_t* p, const float (&x)[16]) { u32x4 a, b;
    a.x = cvt_pk_bf16(x[0], x[1]); a.y = cvt_pk_bf16(x[2], x[3]); a.z = cvt_pk_bf16(x[4], x[5]); a.w = cvt_pk_bf16(x[6], x[7]);
    b.x = cvt_pk_bf16(x[8], x[9]); b.y = cvt_pk_bf16(x[10], x[11]); b.z = cvt_pk_bf16(x[12], x[13]); b.w = cvt_pk_bf16(x[14], x[15]); *(u32x4*)p = a; *(u32x4*)(p + 8) = b; }
template <int HD>
__device__ __forceinline__ void normrope(float (&x)[16], int lane, const float* __restrict__ gain, bool rope, int rowpos, int colpos, const float* __restrict__ rp) {
    float s = 0.f;
#pragma unroll
    for (int e = 0; e < 16; ++e) s += x[e] * x[e];
    s += __shfl_xor(s, 1); s += __shfl_xor(s, 2); if (HD == 128) s += __shfl_xor(s, 4);
    const float rstd = 1.f / sqrtf(s * (1.f / HD) + EPS);
    const int j = lane & (HD / 16 - 1);
#pragma unroll
    for (int e = 0; e < 16; ++e) x[e] = x[e] * rstd * gain[j * 16 + e];
    constexpr int PX = (HD == 128) ? 2 : 1;
    float y[16];
#pragma unroll
    for (int e = 0; e < 16; ++e) y[e] = __shfl_xor(x[e], PX);
    if (rope) {
        const int part = (HD == 128) ? (j >> 2) : (j >> 1), role = (HD == 128) ? ((j >> 1) & 1) : (j & 1), fb = (HD == 128) ? 16 * (j & 1) : 0, pos = part ? colpos : rowpos;
        const float* ct = rp + ((HD == 128) ? 0 : 8192) + pos * (HD / 4) + fb; const float* st = ct + ((HD == 128) ? 4096 : 2048);
#pragma unroll
        for (int e = 0; e < 16; ++e) { const float c = ct[e], sn = st[e]; x[e] = role ? (x[e] * c + y[e] * sn) : (x[e] * c - y[e] * sn); }
    }
}
__device__ __forceinline__ void p6_rows(unsigned char* ws, LAS unsigned char* lds, int l, int gw, int NGW, int lane) {
    asm volatile("" : "+v"(lane));
    const bf16_t* PC = (const bf16_t*)(ws + WS_PIECES); const float* rp = (const float*)(ws + WS_ROPE);
    bf16_t* QS = (bf16_t*)(ws + WS_QS); bf16_t* KS = (bf16_t*)(ws + WS_KS); bf16_t* QD = (bf16_t*)(ws + WS_QD); bf16_t* KD = (bf16_t*)(ws + WS_KD); bf16_t* OB = (bf16_t*)(ws + WS_OB);
    const float* gsq = inp(lds, 12) + l * 128; const float* gsk = inp(lds, 13) + l * 128; const float* gdq = inp(lds, 15) + l * 64; const float* gdk = inp(lds, 16) + l * 64; const float* cw = inp(lds, 11) + (size_t)l * 3 * 1024;
    for (int r = gw; r < T; r += NGW) { const int i = r % TB; const bool lat = i >= CTXL; const int t = i - CTXL, rowpos = (t >> 6) & 127, colpos = t & 63;
        const bf16_t* P = PC + (size_t)r * NIN; float x[16];
        ld16(P + C_SQ + 16 * lane, x); normrope<128>(x, lane, gsq, lat, rowpos, colpos, rp); st16(QS + (size_t)r * 1024 + 16 * lane, x);
        ld16(P + C_SK + 16 * (lane & 15), x); normrope<128>(x, lane, gsk, lat, rowpos, colpos, rp); if (lane < 16) st16(KS + (size_t)r * 256 + 16 * lane, x);
        ld16(P + C_DQ + 16 * lane, x); normrope<64>(x, lane, gdq, lat, rowpos, colpos, rp); st16(QD + (size_t)r * 1024 + 16 * lane, x);
        ld16(P + C_DK + 16 * lane, x); normrope<64>(x, lane, gdk, lat, rowpos, colpos, rp); st16(KD + (size_t)r * 1024 + 16 * lane, x);
        { const int seg_lo = lat ? CTXL : 0, seg_hi = lat ? TB : CTXL; float gc[16], vv[16], y[16];
          ld16(P + C_CONVC + 16 * lane, gc); ld16(P + C_CONVV + 16 * lane, vv);
#pragma unroll
          for (int e = 0; e < 16; ++e) y[e] = gc[e] * vv[e] * cw[1024 + 16 * lane + e];
          if (i - 1 >= seg_lo) { ld16(P - NIN + C_CONVC + 16 * lane, gc); ld16(P - NIN + C_CONVV + 16 * lane, vv);
#pragma unroll
              for (int e = 0; e < 16; ++e) y[e] += gc[e] * vv[e] * cw[16 * lane + e]; }
          if (i + 1 < seg_hi) { ld16(P + NIN + C_CONVC + 16 * lane, gc); ld16(P + NIN + C_CONVV + 16 * lane, vv);
#pragma unroll
              for (int e = 0; e < 16; ++e) y[e] += gc[e] * vv[e] * cw[2048 + 16 * lane + e]; }
          ld16(P + C_CONVB + 16 * lane, gc);
#pragma unroll
          for (int e = 0; e < 16; ++e) y[e] *= gc[e];
          st16(OB + (size_t)r * DM + 1024 + 16 * lane, y); }
    }
}

constexpr int PH_PER_LAYER = 12, N_PHASES = 2 + DEPTH * PH_PER_LAYER;
__global__ void __launch_bounds__(NTHREADS, 2) fwd_kernel(Args args) {
    extern __shared__ __attribute__((aligned(16))) unsigned char lds_raw[];
    LAS unsigned char* lds = (LAS unsigned char*)lds_raw;
    volatile LAS unsigned* MISC = (volatile LAS unsigned*)(lds + MISC_OFF);
    const int tid = threadIdx.x, lane = tid & 63, wave = __builtin_amdgcn_readfirstlane(tid >> 6);
    const int G = gridDim.x, bx = blockIdx.x;
    const int vcu = (G % 8 == 0) ? (bx % 8) * (G / 8) + bx / 8 : bx;
    const int gw = vcu * NWAVES + wave, NGW = G * NWAVES;
    unsigned char* ws = args.ws;
    unsigned* ctl = (unsigned*)(ws + WS_CTL);
    for (int u = tid; u < 64; u += NTHREADS) MISC[u] = 0u;
    if (tid < 22) ((LAS unsigned long long*)(lds + PTR_OFF))[tid] = (unsigned long long)(uintptr_t)args.in[tid];
    __syncthreads();
    XcdBarrier bar; bar.bar = ctl + CW_BAR; bar.x = 0; bar.st = nullptr;
    if (!MK_PER_PHASE) bar = xcd_barrier_post(ctl + CW_BAR, MISC + 8);
    const int lo = args.ph_lo, hi = args.ph_hi;
#ifndef ONLY_SITE
#define ONLY_SITE -1
#endif
#define SITE(s) (ONLY_SITE < 0 || ONLY_SITE == (s))
#ifndef ONLY_SUB
#define ONLY_SUB -1
#endif
#define SUB(s) (ONLY_SUB < 0 || ONLY_SUB == (s))
#define IN(k) (lo <= (k) && (k) < hi)
#define SEAM(k) do { if (IN(k) && IN((k) + 1)) { if (MK_PER_PHASE) { if (tid == 0) __hip_atomic_store(ctl + 1, 0xBAD00000u | (unsigned)(k), RLX_AGENT); } else xcd_barrier(bar); } } while (0)

    if (SITE(0) && IN(0)) { prologue_a(ws, lds, gw, NGW, wave, lane); } SEAM(0);
    if (SITE(1) && IN(1)) { prologue_b(ws, lds, gw, NGW, wave, lane); } SEAM(1);

#define H_ ((bf16_t*)(ws + WS_H))
#define ACT_ ((bf16_t*)(ws + WS_ACT))
#define PIECES_ ((bf16_t*)(ws + WS_PIECES))
#define XS_ ((float*)(ws + WS_XS))
#define OB_ ((bf16_t*)(ws + WS_OB))
#define SIG_ ((bf16_t*)(ws + WS_SIG))
#define MG_ ((bf16_t*)(ws + WS_MG))
#define WL_ (ws + WS_W + (size_t)l * WL_SIZE)
#define MODL_ ((const float*)(ws + WS_MOD) + (size_t)(l * 3) * NMOD * DM)
    for (int it = 0; it < 2 * DEPTH; ++it) {
        const int l = it >> 1, hf = it & 1, kidx = hf ? 2 : 0, pb = 2 + PH_PER_LAYER * l + (hf ? 9 : 0);
        if (SITE(2) && IN(pb + 0)) { norm_phase(ws, lds, l, kidx, gw, NGW, tid, lane); } SEAM(pb + 0);
        if (SITE(3) && IN(pb + 1)) {
            pg8::Gemm g{H_, (const bf16_t*)(WL_ + WL_W13) + (size_t)hf * 2 * DFF * DM, DM, DM, DM, 0, 0}; pg8::Order S; S.init(T / 256, 2 * DFF / 256, 1, G, bx, 1);
            pg8::EpiSwiGLU E{ACT_, DFF};
            pg8::gemm_phase<pg8::EpiSwiGLU, true, true>(lds, g, S, E);
        } SEAM(pb + 1);
        if (SITE(4) && IN(pb + 2)) {
            pg8::Gemm g{ACT_, (const bf16_t*)(WL_ + WL_W2) + (size_t)hf * DM * DFF, DFF, DFF, DFF, 0, 0}; pg8::Order S; S.init(T / 256, DM / 256, 1, G, bx, 1);
            pg8::EpiResid<true> E{XS_, MODL_ + (size_t)(kidx * 3 + 2) * DM, args.out, (it == 2 * DEPTH - 1) ? 1 : 0};
            pg8::gemm_phase<pg8::EpiResid<true>, true, true>(lds, g, S, E);
        } SEAM(pb + 2);
        if (hf) continue;
        const int mb = pb + 3;
        if (SITE(5) && IN(mb + 0)) { norm_phase(ws, lds, l, 1, gw, NGW, tid, lane); } SEAM(mb + 0);
        if (SITE(6) && IN(mb + 1)) {
            pg8::Gemm g{H_, (const bf16_t*)(WL_ + WL_WIN), DM, DM, DM, 0, 0}; pg8::Order S; S.init(T / 256, NIN / 256, 1, G, bx, 1);
            pg8::EpiBf16 E{PIECES_, NIN, 0, 0, 1.f};
            pg8::gemm_phase<pg8::EpiBf16, true, true>(lds, g, S, E);
        } SEAM(mb + 1);
        if (SITE(7) && IN(mb + 2)) {
            if (SUB(0)) {
                pg8::Gemm g{(const bf16_t*)(ws + WS_CSCT), PIECES_ + C_FOUR, 256, 256, NIN, 0, 256}; pg8::Order S; S.init(2, T / 256, 4, G, bx, 1);
                pg8::EpiChan E{(bf16_t*)(ws + WS_ABT), (bf16_t*)(ws + WS_ABTC)};
                pg8::gemm_phase<pg8::EpiChan, true, true>(lds, g, S, E);
            }
            if (SUB(1)) {
                pg8::Gemm g{PIECES_ + C_Z, (const bf16_t*)(WL_ + WL_GATE), 256, NIN, 256, 0, 0}; pg8::Order S; S.init(T / 256, 16384 / 256, 1, G, bx, 1);
                pg8::EpiSig E{SIG_, 16384};
                pg8::gemm_phase<pg8::EpiSig, true, true>(lds, g, S, E);
            }
            if (SUB(2)) p6_rows(ws, lds, l, gw, NGW, lane);
        } SEAM(mb + 2);
        if (SITE(8) && IN(mb + 3)) {
            if (SUB(0)) {
                pg8::Gemm g{(const bf16_t*)(ws + WS_CS), (const bf16_t*)(ws + WS_ABT), 16384, 16384, 16384, 0, (long)1024 * 16384}; pg8::Order S; S.init(SEQ / 256, 4, 2, G, bx, 1);
                pg8::EpiBf16 E{OB_, DM, CTXL, TB, 6.9053396600248786e-4f};
                pg8::gemm_phase<pg8::EpiBf16, true, true>(lds, g, S, E);
            }
            if (SUB(1)) {
                pg8::Gemm g{(const bf16_t*)(ws + WS_CSCTX), (const bf16_t*)(ws + WS_ABTC), 512, 512, 512, 0, (long)1024 * 512}; pg8::Order S; S.init(1, 4, 2, G, bx, 1);
                pg8::EpiBf16 E{OB_, DM, 0, TB, 1.f / 256.f};
                pg8::gemm_phase<pg8::EpiBf16, true, true>(lds, g, S, E);
            }
            __syncthreads();
            const int wid = wave;
            const float* lamp = (const float*)(ws + WS_LAM); const float lam = lamp[l], oml = lamp[4 + l];
            if (SUB(2)) for (int u = bx; u < 512 + 16; u += G) {
                int b, h, q0, NT;
                if (u < 512) { b = u >> 8; h = (u >> 5) & 7; q0 = CTXL + (u & 31) * 256; NT = TB / 64; } else { const int v = u - 512; b = v >> 3; h = v & 7; q0 = 0; NT = CTXL / 64; }
                const size_t rb = (size_t)b * TB; float* O1 = (float*)(ws + WS_O1);
                for (int c = 0; c < 2; ++c) {
                    f32x16 o[4];
                    att::attn_unit<64, false, 1024, 1024, NIN>((const bf16_t*)(ws + WS_QD) + (rb + q0) * 1024 + (2 * h + c) * 64, (const bf16_t*)(ws + WS_KD) + rb * 1024 + (2 * h + c) * 64,
                                              (const bf16_t*)(ws + WS_PIECES) + rb * NIN + C_DV + h * 128, NT, 0, 0, 0, -1e30f, 0.f, (LAS char*)lds, o);
                    int ln = lane; asm volatile("" : "+v"(ln));
                    const int r32 = ln & 31, hi5 = ln >> 5;
                    float* O1b = O1 + (rb + q0 + wid * 32) * 1024 + h * 128;
                    const unsigned lo1 = (unsigned)(4 * hi5 * 1024 + r32);
                    if (c == 0) {
#pragma unroll
                        for (int r = 0; r < 16; ++r) { float* p = O1b + ((r & 3) + 8 * (r >> 2)) * 1024 + lo1;
#pragma unroll
                            for (int d = 0; d < 4; ++d) p[d * 32] = o[d][r];
                            asm volatile("" ::: "memory"); }
                    } else {
                        const float* sub = inp(lds, 18) + l * 128; float sg[4];
#pragma unroll
                        for (int d = 0; d < 4; ++d) sg[d] = sub[d * 32 + r32] * oml;
                        bf16_t* OBb = (bf16_t*)(ws + WS_OB) + (rb + q0 + wid * 32) * DM + 3072 + h * 128;
                        const unsigned lo2 = (unsigned)(4 * hi5 * DM + r32);
#pragma unroll
                        for (int r = 0; r < 16; ++r) { const float* p = O1b + ((r & 3) + 8 * (r >> 2)) * 1024 + lo1; float dv[4], ss = 0.f;
#pragma unroll
                            for (int d = 0; d < 4; ++d) { dv[d] = p[d * 32] - lam * o[d][r]; ss += dv[d] * dv[d]; }
                            ss += __shfl_xor(ss, 1); ss += __shfl_xor(ss, 2); ss += __shfl_xor(ss, 4); ss += __shfl_xor(ss, 8); ss += __shfl_xor(ss, 16);
                            const float rstd = 1.f / sqrtf(ss * (1.f / 128.f) + EPS); bf16_t* q = OBb + ((r & 3) + 8 * (r >> 2)) * DM + lo2;
#pragma unroll
                            for (int d = 0; d < 4; ++d) q[d * 32] = (bf16_t)(cvt_pk_bf16(dv[d] * rstd * sg[d], 0.f) & 0xffffu);
                            asm volatile("" ::: "memory"); }
                    }
                }
            }
            if (SUB(3)) for (int u = bx; u < 512 + 16; u += G) {
                int b, h, q0, NT, i0;
                if (u < 512) { b = u >> 8; h = (u >> 5) & 7; i0 = (u & 31) * 256; q0 = CTXL + i0; NT = 12; } else { const int v = u - 512; b = v >> 3; h = v & 7; i0 = 0; q0 = 0; NT = 4; }
                const size_t rb = (size_t)b * TB; const float sink = inp(lds, 14)[l * 8 + h];
                f32x16 o[4];
                att::attn_unit<128, true, 1024, 256, NIN>((const bf16_t*)(ws + WS_QS) + (rb + q0) * 1024 + h * 128, (const bf16_t*)(ws + WS_KS) + rb * 256 + (h >> 2) * 128,
                                          (const bf16_t*)(ws + WS_PIECES) + rb * NIN + C_SV + (h >> 2) * 128, NT, 4, i0 - 128, i0, sink * 11.313708498984761f, 1.f, (LAS char*)lds, o);
                int ln = lane; asm volatile("" : "+v"(ln));
                const int r32 = ln & 31, hi5 = ln >> 5;
                bf16_t* OBb = (bf16_t*)(ws + WS_OB) + (rb + q0 + wid * 32) * DM + 2048 + h * 128;
                const unsigned lo2 = (unsigned)(4 * hi5 * DM + r32);
#pragma unroll
                for (int r = 0; r < 16; ++r) { bf16_t* q = OBb + ((r & 3) + 8 * (r >> 2)) * DM + lo2;
#pragma unroll
                    for (int d = 0; d < 4; ++d) q[d * 32] = (bf16_t)(cvt_pk_bf16(o[d][r], 0.f) & 0xffffu);
                    asm volatile("" ::: "memory"); }
            }
        } SEAM(mb + 3);
        if (SITE(9) && IN(mb + 4)) {
            pg8::Gemm g{OB_, (const bf16_t*)(WL_ + WL_WB), 1024, DM, DM, 1024, 1024}; pg8::Order S; S.init(T / 256, DM / 256, 1, G, bx, 4);
            pg8::EpiMerge E{SIG_, (float*)(ws + WS_PART), MG_};
            pg8::gemm_phase<pg8::EpiMerge, true, true>(lds, g, S, E);
        } SEAM(mb + 4);
        if (SITE(10) && IN(mb + 5)) {
            pg8::Gemm g{MG_, (const bf16_t*)(WL_ + WL_WO), DM, DM, DM, 0, 0}; pg8::Order S; S.init(T / 256, DM / 256, 1, G, bx, 1);
            pg8::EpiResid<false> E{XS_, MODL_ + (size_t)5 * DM, args.out, 0};
            pg8::gemm_phase<pg8::EpiResid<false>, true, true>(lds, g, S, E);
        } SEAM(mb + 5);
    }
#undef IN
#undef SEAM
}

#ifndef DBG_NRUN
#define DBG_NRUN 0
#endif
struct DbgSeg { size_t off, n; int bf16; };
#ifndef DBG_SEGS
#define DBG_SEGS {WS_SIG, (size_t)T * 16384, 1}
#endif
__global__ void dbg_dump(const unsigned char* ws, float* out, size_t nout) {
    const DbgSeg segs[] = {DBG_SEGS}; constexpr int NS = sizeof(segs) / sizeof(segs[0]);
    for (size_t i = (size_t)blockIdx.x * blockDim.x + threadIdx.x; i < nout; i += (size_t)gridDim.x * blockDim.x) {
        size_t j = i; int k = 0;
#pragma unroll
        for (int q = 0; q < NS - 1; ++q) if (k == q && j >= segs[q].n) { j -= segs[q].n; k = q + 1; }
        j = j % segs[k].n;
        float v = 0.f;
#pragma unroll
        for (int q = 0; q < NS; ++q) if (k == q) v = segs[q].bf16 ? __uint_as_float((unsigned)((const bf16_t*)(ws + segs[q].off))[j] << 16) : ((const float*)(ws + segs[q].off))[j];
        out[i] = v;
    }
}
extern "C" void kernel_launch(void* const* d_in, const int* in_sizes, int n_in, void* d_out, int out_size, void* d_ws, size_t ws_size, hipStream_t stream) {
    static int grid = 0;
    if (grid == 0) {
        if (n_in != 22 || out_size != NBATCH * SEQ * DM || ws_size < WS_END) { fprintf(stderr, "kernel_launch: unexpected shapes: n_in %d out %d ws %zu (need %zu)\n", n_in, out_size, ws_size, (size_t)WS_END); grid = -1; return; }
        int dev = 0, cus = 0, per_cu = 0;
        if (hipGetDevice(&dev) != hipSuccess || hipDeviceGetAttribute(&cus, hipDeviceAttributeMultiprocessorCount, dev) != hipSuccess) { grid = -1; return; }
        if (hipFuncSetAttribute((const void*)fwd_kernel, hipFuncAttributeMaxDynamicSharedMemorySize, LDS_BYTES) != hipSuccess) { fprintf(stderr, "kernel_launch: hipFuncSetAttribute failed\n"); grid = -1; return; }
        if (hipOccupancyMaxActiveBlocksPerMultiprocessor(&per_cu, (const void*)fwd_kernel, NTHREADS, LDS_BYTES) != hipSuccess || per_cu < 1) { fprintf(stderr, "kernel_launch: occupancy query says %d\n", per_cu); }
        (void)hipGetLastError();
        grid = cus;
    }
    if (grid < 0) return;
    (void)hipMemsetAsync((char*)d_ws + WS_CTL, 0, CTL_ZERO_BYTES, stream);
    Args a{};
    for (int i = 0; i < 22; ++i) a.in[i] = (const float*)d_in[i];
    a.out = (float*)d_out; a.ws = (unsigned char*)d_ws;
#if DBG_NRUN > 0
    for (int p = 0; p < DBG_NRUN; ++p) { a.ph_lo = p; a.ph_hi = p + 1; hipLaunchKernelGGL(fwd_kernel, dim3(grid), dim3(NTHREADS), LDS_BYTES, stream, a); }
    hipLaunchKernelGGL(dbg_dump, dim3(2048), dim3(256), 0, stream, (const unsigned char*)d_ws, (float*)d_out, (size_t)out_size);
#elif MK_PER_PHASE
    for (int p = 0; p < N_PHASES; ++p) { a.ph_lo = p; a.ph_hi = p + 1; hipLaunchKernelGGL(fwd_kernel, dim3(grid), dim3(NTHREADS), LDS_BYTES, stream, a); }
#else
    a.ph_lo = 0; a.ph_hi = N_PHASES;
    hipLaunchKernelGGL(fwd_kernel, dim3(grid), dim3(NTHREADS), LDS_BYTES, stream, a);
#endif
    const hipError_t le = hipPeekAtLastError();
    if (le != hipSuccess) fprintf(stderr, "kernel_launch: launch failed: %s\n", hipGetErrorName(le));
}
```

```cpp
#include <hip/hip_runtime.h>
#include <cstdio>
#include <cstdint>

#ifndef MK_PER_PHASE
#define MK_PER_PHASE 0
#endif

#define LAS __attribute__((address_space(3)))
#define GAS __attribute__((address_space(1)))
typedef unsigned short bf16_t;
typedef short bf16x8 __attribute__((ext_vector_type(8)));
typedef short s16x4 __attribute__((ext_vector_type(4)));
typedef float f32x2 __attribute__((ext_vector_type(2)));
typedef float f32x4 __attribute__((ext_vector_type(4)));
typedef float f32x16 __attribute__((ext_vector_type(16)));
typedef unsigned u32x2 __attribute__((ext_vector_type(2)));
typedef unsigned u32x4 __attribute__((ext_vector_type(4)));

constexpr int DM = 4096, NBATCH = 2, SEQ = 8192, DEPTH = 4, CTXL = 256, TB = CTXL + SEQ, T = NBATCH * TB, DFF = 5120, NIN = 8960, NMOD = 9;
constexpr int PANB = TB / 256;
constexpr int C_FOUR = 0, C_CONVB = 1024, C_CONVC = 2048, C_CONVV = 3072, C_SQ = 4096, C_SK = 5120, C_SV = 5376, C_DQ = 5632, C_DK = 6656, C_DV = 7680, C_Z = 8704;
constexpr float EPS = 1e-6f;
constexpr int NWAVES = 8, NTHREADS = 512;

constexpr size_t MiB = 1u << 20;
constexpr size_t WS_CTL = 0, CTL_ZERO_BYTES = 64 * 1024;
constexpr size_t WS_ROPE = 1 * MiB;
constexpr size_t WS_LAM = 1 * MiB + 512 * 1024;
constexpr size_t WS_T1P = 2 * MiB;
constexpr size_t WS_MOD = 3 * MiB;
constexpr size_t WS_CSCT = 5 * MiB;
constexpr size_t WS_CSCTX = 5 * MiB + 512 * 1024;
constexpr size_t WS_CS = 6 * MiB;
constexpr size_t WS_W = 262 * MiB;
constexpr size_t WL_W13 = 0, WL_W2 = 160 * MiB, WL_WIN = 240 * MiB, WL_WB = 310 * MiB, WL_GATE = 342 * MiB, WL_WO = 350 * MiB, WL_SIZE = 382 * MiB;
constexpr size_t WS_XS = WS_W + DEPTH * WL_SIZE;
constexpr size_t WS_H = WS_XS + 264 * MiB;
constexpr size_t WS_ACT = WS_H + 132 * MiB;
constexpr size_t WS_PIECES = WS_ACT + 165 * MiB;
constexpr size_t WS_QS = WS_PIECES + 289 * MiB;
constexpr size_t WS_KS = WS_QS + 33 * MiB;
constexpr size_t WS_QD = WS_KS + 9 * MiB;
constexpr size_t WS_KD = WS_QD + 33 * MiB;
constexpr size_t WS_ABT = WS_KD + 33 * MiB;
constexpr size_t WS_ABTC = WS_ABT + 64 * MiB;
constexpr size_t WS_OB = WS_ABTC + 2 * MiB;
constexpr size_t WS_SIG = WS_OB + 132 * MiB;
constexpr size_t WS_PART = WS_SIG + 528 * MiB;
constexpr size_t WS_MG = WS_PART + 264 * MiB;
constexpr size_t WS_O1 = WS_MG + 132 * MiB;
constexpr size_t WS_END = WS_O1 + 66 * MiB;
constexpr int CW_BAR = 4096;

constexpr int LDS_BYTES = 147456;
constexpr int MISC_OFF = 144 * 1024 - 256;
constexpr int PTR_OFF = MISC_OFF - 256;

#define RLX_AGENT __ATOMIC_RELAXED, __HIP_MEMORY_SCOPE_AGENT
#define LDS_WAIT() asm volatile("s_waitcnt lgkmcnt(0)" ::: "memory")
#define VM_WAIT() asm volatile("s_waitcnt vmcnt(0)" ::: "memory")
typedef __bf16 bf16x2_t __attribute__((ext_vector_type(2)));
__device__ __forceinline__ unsigned cvt_pk_bf16(float lo, float hi) { const f32x2 v = {lo, hi}; const bf16x2_t b = __builtin_convertvector(v, bf16x2_t); return __builtin_bit_cast(unsigned, b); }
__device__ __forceinline__ float bf_lo(unsigned w) { return __uint_as_float(w << 16); }
__device__ __forceinline__ float bf_hi(unsigned w) { return __uint_as_float(w & 0xffff0000u); }
__device__ __forceinline__ float fast_rcp(float x) { return __builtin_amdgcn_rcpf(x); }
__device__ __forceinline__ float sigmoidf_(float x) { return fast_rcp(1.f + __builtin_amdgcn_exp2f(-1.4426950408889634f * x)); }

namespace pg8 {
constexpr int BM = 256, BK = 64, HALF = 128, HTB = HALF * BK * 2, STAGE_BYTES = 8 * HTB, NXCD = 8, WGM = 8;
__host__ __device__ __forceinline__ int lds_byte(int r, int c) { const int st = (r >> 4) * 2 + (c >> 5), rr = r & 15, cc = c & 31, ob = rr * 64 + cc * 2; return st * 1024 + (ob ^ (((ob >> 9) & 1) << 5)); }
__host__ __device__ __forceinline__ void stage_rc(int b, int& R, int& C) { const int st = b / 1024, sb = b % 1024, swz = sb ^ (((sb >> 9) & 1) << 5); R = (st >> 1) * 16 + swz / 64; C = (st & 1) * 32 + (swz % 64) / 2; }
__host__ __device__ __forceinline__ int perm32(int rho) { const int n = rho >> 4, i = rho & 15; return 8 * (i >> 2) + 4 * n + (i & 3); }

struct Unit { int pm, pn, pz; };
struct Gemm { const bf16_t* A; const bf16_t* Bt; int K, lda, ldb; long bsA, bsB; };

struct Order {
    int nM, nN, nZ, nwg, G, c, rep;
    __device__ __forceinline__ void init(int nM_, int nN_, int nZ_, int G_, int c_, int rep_) { nM = nM_; nN = nN_; nZ = nZ_; nwg = nM * nN; G = G_; c = c_; rep = rep_; }
    __device__ __forceinline__ bool next(int i, Unit& u) const {
        long L; int pz;
        if (rep == 1) { L = (long)i * G + c; if (L >= (long)nwg * nZ) return false; pz = (int)(L / nwg); L = L % nwg; }
        else { L = (long)(i / rep) * G + c; if (L >= nwg) return false; pz = i % rep; }
        int wgid = (int)L; { const int q = nwg / NXCD, r = nwg % NXCD, xcd = wgid % NXCD, off = wgid / NXCD; wgid = (xcd < r ? xcd * (q + 1) : r * (q + 1) + (xcd - r) * q) + off; }
        const int nig = WGM * nN, gid = wgid / nig, fm = gid * WGM, gsz = (nM - fm) < WGM ? (nM - fm) : WGM;
        u.pm = fm + ((wgid % nig) % gsz); u.pn = (wgid % nig) / gsz; u.pz = pz; return true;
    }
};

typedef f32x4 Acc[2][2][4][2];

template <class Epi, bool ALIGN_EPI, bool SP2>
__device__ __forceinline__ void gemm_phase(LAS unsigned char* lds, const Gemm g, const Order S, const Epi E) {
    int tid_ = threadIdx.x; asm volatile("" : "+v"(tid_));
    const int tid = tid_, wid = __builtin_amdgcn_readfirstlane(tid >> 6), lane = tid & 63, wr = wid >> 2, wc = wid & 3, fr = lane & 15, fq = lane >> 4;
    const int K = g.K, nt = K / BK;
    unsigned voffA[2], voffB[2];
#pragma unroll
    for (int i = 0; i < 2; ++i) { int R, C; stage_rc(tid * 16 + i * 8192, R, C); const int Rb = Epi::PERM ? ((R & ~31) + perm32(R & 31)) : R;
        voffA[i] = (unsigned)(R * g.lda + C) * 2u; voffB[i] = (unsigned)(Rb * g.ldb + C) * 2u; }
    const size_t kstep = (size_t)(BK * 2);
    const size_t hstepA = (size_t)HALF * g.lda * 2, hstepB = (size_t)HALF * g.ldb * 2;
    const size_t tstepA = 2 * hstepA, tstepB = 2 * hstepB;
    const unsigned ldsw = (unsigned)wid * 1024u;
    const int aoff = lds_byte(wr * 64 + fr, fq * 8), boff = lds_byte(wc * 32 + fr, fq * 8);
#define PG8_SA(b, h) (((b) * 2 + (h)) * HTB)
#define PG8_SB(b, h) ((4 + (b) * 2 + (h)) * HTB)
#define PG8_STAGE(bufoff, gbase, voff) do { _Pragma("unroll") for (int _i = 0; _i < 2; ++_i) \
        __builtin_amdgcn_global_load_lds((const unsigned*)((const char*)(gbase) + (voff)[_i]), (LAS unsigned*)(lds + (bufoff) + ldsw + _i * 8192), 16, 0, 0); } while (0)
#define PG8_LDA(dst, b, h) do { _Pragma("unroll") for (int m = 0; m < 4; ++m) _Pragma("unroll") for (int k = 0; k < 2; ++k) dst[m][k] = *(const LAS bf16x8*)(lds + PG8_SA(b, h) + aoff + m * 2048 + k * 1024); } while (0)
#define PG8_LDB(dst, b, h) do { _Pragma("unroll") for (int n = 0; n < 2; ++n) _Pragma("unroll") for (int k = 0; k < 2; ++k) dst[n][k] = *(const LAS bf16x8*)(lds + PG8_SB(b, h) + boff + n * 2048 + k * 1024); } while (0)
#define PG8_MMA(ai, bj, At, Bt) do { __builtin_amdgcn_s_setprio(1); _Pragma("unroll") for (int m = 0; m < 4; ++m) _Pragma("unroll") for (int n = 0; n < 2; ++n) _Pragma("unroll") for (int k = 0; k < 2; ++k) \
        acc[ai][bj][m][n] = __builtin_amdgcn_mfma_f32_16x16x32_bf16(Bt[n][k], At[m][k], acc[ai][bj][m][n], 0, 0, 0); __builtin_amdgcn_s_setprio(0); } while (0)
#define PG8_WAIT_V(n) asm volatile("s_waitcnt vmcnt(" #n ")" ::: "memory")
#define PG8_WAIT_L(n) asm volatile("s_waitcnt lgkmcnt(" #n ")" ::: "memory")
#define PG8_BAR __builtin_amdgcn_s_barrier()
#define PG8_SCHED __builtin_amdgcn_sched_barrier(0)
    Unit cur, nxt; int ui = 0;
    if (!S.next(0, cur)) return;
    Acc acc;
#pragma unroll
    for (int a = 0; a < 2; ++a)
#pragma unroll
        for (int b = 0; b < 2; ++b)
#pragma unroll
            for (int m = 0; m < 4; ++m)
#pragma unroll
                for (int n = 0; n < 2; ++n) acc[a][b][m][n] = (f32x4){0.f, 0.f, 0.f, 0.f};
    bf16x8 At[4][2], B0[2][2], B1[2][2];
    const char* cA = (const char*)g.A + (size_t)cur.pm * tstepA + (size_t)cur.pz * g.bsA * 2; const char* cB = (const char*)g.Bt + (size_t)cur.pn * tstepB + (size_t)cur.pz * g.bsB * 2;
    if constexpr (SP2) {
        PG8_STAGE(PG8_SB(0, 0), cB, voffB); PG8_STAGE(PG8_SB(0, 1), cB + hstepB, voffB); PG8_STAGE(PG8_SA(0, 0), cA, voffA); PG8_STAGE(PG8_SA(0, 1), cA + hstepA, voffA);
        if (wr == 1) PG8_BAR;
        PG8_WAIT_V(2); PG8_BAR;
        PG8_STAGE(PG8_SB(1, 0), cB + kstep, voffB); PG8_STAGE(PG8_SA(1, 0), cA + kstep, voffA); PG8_STAGE(PG8_SB(1, 1), cB + hstepB + kstep, voffB);
        PG8_WAIT_V(6); PG8_BAR;
    } else {
        PG8_STAGE(PG8_SB(0, 0), cB, voffB); PG8_STAGE(PG8_SA(0, 0), cA, voffA); PG8_STAGE(PG8_SB(0, 1), cB + hstepB, voffB); PG8_STAGE(PG8_SA(0, 1), cA + hstepA, voffA);
        if (wr == 1) PG8_BAR;
        PG8_WAIT_V(4); PG8_BAR;
        PG8_STAGE(PG8_SB(1, 0), cB + kstep, voffB); PG8_STAGE(PG8_SA(1, 0), cA + kstep, voffA); PG8_STAGE(PG8_SB(1, 1), cB + hstepB + kstep, voffB);
        PG8_WAIT_V(6); PG8_BAR;
    }
    for (;;) {
        const bool has_next = S.next(ui + 1, nxt);
        const char* nA = has_next ? (const char*)g.A + (size_t)nxt.pm * tstepA + (size_t)nxt.pz * g.bsA * 2 : cA;
        const char* nB = has_next ? (const char*)g.Bt + (size_t)nxt.pn * tstepB + (size_t)nxt.pz * g.bsB * 2 : cB;
#pragma nounroll
        for (int t = 0; t < nt; t += 2) {
            const bool last = (t == nt - 2);
            const char* a1 = cA + (size_t)(t + 1) * kstep;
            const char* a2 = last ? nA : cA + (size_t)(t + 2) * kstep; const char* b2 = last ? nB : cB + (size_t)(t + 2) * kstep;
            const char* a3 = a2 + kstep; const char* b3 = b2 + kstep;
            if constexpr (Epi::HOOK) E.hook(acc, cur, t, wr, wc, fr, fq);
            if constexpr (SP2) {
            PG8_LDB(B0, 0, 0); PG8_LDB(B1, 0, 1); PG8_SCHED; PG8_LDA(At, 0, 0); PG8_STAGE(PG8_SA(1, 1), a1 + hstepA, voffA);
            PG8_WAIT_V(8); PG8_WAIT_L(0); PG8_BAR; PG8_MMA(0, 0, At, B0); PG8_MMA(0, 1, At, B1); PG8_BAR; PG8_SCHED;
            PG8_LDA(At, 0, 1); PG8_STAGE(PG8_SB(0, 0), b2, voffB); PG8_STAGE(PG8_SB(0, 1), b2 + hstepB, voffB); PG8_STAGE(PG8_SA(0, 0), a2, voffA);
            PG8_WAIT_V(8); PG8_WAIT_L(0); PG8_BAR; PG8_MMA(1, 0, At, B0); PG8_MMA(1, 1, At, B1); PG8_BAR; PG8_SCHED;
            PG8_LDB(B0, 1, 0); PG8_LDB(B1, 1, 1); PG8_SCHED; PG8_LDA(At, 1, 0); PG8_STAGE(PG8_SA(0, 1), a2 + hstepA, voffA);
            PG8_WAIT_V(8); PG8_WAIT_L(0); PG8_BAR; PG8_MMA(0, 0, At, B0); PG8_MMA(0, 1, At, B1); PG8_BAR; PG8_SCHED;
            PG8_LDA(At, 1, 1); PG8_STAGE(PG8_SB(1, 0), b3, voffB); PG8_STAGE(PG8_SB(1, 1), b3 + hstepB, voffB); PG8_STAGE(PG8_SA(1, 0), a3, voffA);
            PG8_WAIT_V(8); PG8_WAIT_L(0); PG8_BAR; PG8_MMA(1, 0, At, B0); PG8_MMA(1, 1, At, B1); PG8_BAR; PG8_SCHED;
            } else {
            PG8_LDB(B0, 0, 0); PG8_SCHED; PG8_LDA(At, 0, 0); PG8_STAGE(PG8_SA(1, 1), a1 + hstepA, voffA);
            PG8_WAIT_L(8); PG8_BAR; PG8_WAIT_L(0); PG8_MMA(0, 0, At, B0); PG8_BAR; PG8_SCHED;
            PG8_LDB(B1, 0, 1); PG8_STAGE(PG8_SB(0, 0), b2, voffB);
            PG8_BAR; PG8_WAIT_L(0); PG8_MMA(0, 1, At, B1); PG8_BAR;
            PG8_LDA(At, 0, 1); PG8_STAGE(PG8_SA(0, 0), a2, voffA);
            PG8_BAR; PG8_WAIT_L(0); PG8_MMA(1, 0, At, B0); PG8_BAR; PG8_SCHED;
            PG8_STAGE(PG8_SB(0, 1), b2 + hstepB, voffB);
            PG8_WAIT_V(6); PG8_BAR; PG8_MMA(1, 1, At, B1); PG8_BAR;
            PG8_LDB(B0, 1, 0); PG8_SCHED; PG8_LDA(At, 1, 0); PG8_STAGE(PG8_SA(0, 1), a2 + hstepA, voffA);
            PG8_WAIT_L(8); PG8_BAR; PG8_WAIT_L(0); PG8_MMA(0, 0, At, B0); PG8_BAR; PG8_SCHED;
            PG8_LDB(B1, 1, 1); PG8_STAGE(PG8_SB(1, 0), b3, voffB);
            PG8_BAR; PG8_WAIT_L(0); PG8_MMA(0, 1, At, B1); PG8_BAR;
            PG8_LDA(At, 1, 1); PG8_STAGE(PG8_SA(1, 0), a3, voffA);
            PG8_BAR; PG8_WAIT_L(0); PG8_MMA(1, 0, At, B0); PG8_BAR; PG8_SCHED;
            PG8_STAGE(PG8_SB(1, 1), b3 + hstepB, voffB);
            PG8_WAIT_V(6); PG8_BAR; PG8_MMA(1, 1, At, B1); PG8_BAR;
            }
        }
        if constexpr (ALIGN_EPI) { if (wr == 0) PG8_BAR; }
        E(acc, cur, wr, wc, fr, fq);
        if (!has_next) break;
#pragma unroll
        for (int a = 0; a < 2; ++a)
#pragma unroll
            for (int b = 0; b < 2; ++b)
#pragma unroll
                for (int m = 0; m < 4; ++m)
#pragma unroll
                    for (int n = 0; n < 2; ++n) acc[a][b][m][n] = (f32x4){0.f, 0.f, 0.f, 0.f};
        cur = nxt; cA = nA; cB = nB; ++ui;
        if constexpr (ALIGN_EPI) { if (wr == 1) PG8_BAR; }
    }
    PG8_WAIT_V(0);
    if constexpr (!ALIGN_EPI) { if (wr == 0) PG8_BAR; }
    PG8_BAR;
#undef PG8_SA
#undef PG8_SB
#undef PG8_STAGE
#undef PG8_LDA
#undef PG8_LDB
#undef PG8_MMA
#undef PG8_WAIT_V
#undef PG8_WAIT_L
#undef PG8_BAR
#undef PG8_SCHED
}

struct EpiBf16 {
    static constexpr bool PERM = true, HOOK = false;
    bf16_t* O; int ldc; long rbase, zstride; float scale;
    __device__ __forceinline__ void operator()(const Acc& acc, const Unit& u, int wr, int wc, int fr, int fq) const {
        const long row0 = rbase + (long)u.pz * zstride + u.pm * BM + wr * 64 + fr; const int col0 = u.pn * BM + wc * 32 + 8 * fq;
#pragma unroll
        for (int ai = 0; ai < 2; ++ai)
#pragma unroll
            for (int m = 0; m < 4; ++m) { bf16_t* rowp = O + (size_t)(row0 + ai * HALF + m * 16) * ldc + col0;
#pragma unroll
                for (int bj = 0; bj < 2; ++bj) { const f32x4 v0 = acc[ai][bj][m][0] * scale, v1 = acc[ai][bj][m][1] * scale;
                    u32x4 w; w.x = cvt_pk_bf16(v0[0], v0[1]); w.y = cvt_pk_bf16(v0[2], v0[3]); w.z = cvt_pk_bf16(v1[0], v1[1]); w.w = cvt_pk_bf16(v1[2], v1[3]);
                    *(u32x4*)(rowp + bj * HALF) = w; }
                asm volatile("" ::: "memory"); }
    }
};
struct EpiSwiGLU {
    static constexpr bool PERM = true, HOOK = false;
    bf16_t* O; int ldc;
    __device__ __forceinline__ void operator()(const Acc& acc, const Unit& u, int wr, int wc, int fr, int fq) const {
        const int row0 = u.pm * BM + wr * 64 + fr, col0 = u.pn * HALF + wc * 32 + 8 * fq;
#pragma unroll
        for (int ai = 0; ai < 2; ++ai)
#pragma unroll
            for (int m = 0; m < 4; ++m) { bf16_t* rowp = O + (size_t)(row0 + ai * HALF + m * 16) * ldc + col0;
                float v[8];
#pragma unroll
                for (int n = 0; n < 2; ++n)
#pragma unroll
                    for (int j = 0; j < 4; ++j) { const float a = acc[ai][0][m][n][j], g = acc[ai][1][m][n][j]; v[n * 4 + j] = a * sigmoidf_(a) * g; }
                u32x4 w; w.x = cvt_pk_bf16(v[0], v[1]); w.y = cvt_pk_bf16(v[2], v[3]); w.z = cvt_pk_bf16(v[4], v[5]); w.w = cvt_pk_bf16(v[6], v[7]);
                *(u32x4*)rowp = w; asm volatile("" ::: "memory"); }
    }
};
template <bool HALFSTEP>
struct EpiResid {
    static constexpr bool PERM = false, HOOK = false;
    float* X; const float* coef; float* dout; int fin;
    __device__ __forceinline__ void operator()(const Acc& acc, const Unit& u, int wr, int wc, int fr, int fq) const {
        constexpr float f = HALFSTEP ? 0.5f : 1.f;
        const int b = u.pm / PANB, ip = u.pm % PANB, v = (ip == 0) ? 2 : b;
        if (!(fin && ip == 0)) {
        const int row0 = u.pm * BM + wr * 64 + fr, col0 = u.pn * BM + wc * 32 + 4 * fq;
        const float* cf = coef + (size_t)v * (NMOD * DM) + col0;
        f32x4 cv[2][2];
#pragma unroll
        for (int bj = 0; bj < 2; ++bj)
#pragma unroll
            for (int n = 0; n < 2; ++n) cv[bj][n] = *(const f32x4*)(cf + bj * HALF + n * 16) * f;
        const float* sbase = X + (size_t)row0 * DM + col0;
        float* dbase = fin ? dout + (size_t)(row0 - CTXL * (b + 1)) * DM + col0 : X + (size_t)row0 * DM + col0;
#pragma unroll
        for (int ai = 0; ai < 2; ++ai) { f32x4 x[4][2][2];
#pragma unroll
            for (int m = 0; m < 4; ++m)
#pragma unroll
                for (int bj = 0; bj < 2; ++bj)
#pragma unroll
                    for (int n = 0; n < 2; ++n) x[m][bj][n] = *(const f32x4*)(sbase + (size_t)(ai * HALF + m * 16) * DM + bj * HALF + n * 16);
#pragma unroll
            for (int m = 0; m < 4; ++m)
#pragma unroll
                for (int bj = 0; bj < 2; ++bj)
#pragma unroll
                    for (int n = 0; n < 2; ++n) *(f32x4*)(dbase + (size_t)(ai * HALF + m * 16) * DM + bj * HALF + n * 16) = x[m][bj][n] + cv[bj][n] * acc[ai][bj][m][n];
            asm volatile("" ::: "memory"); }
        }
    }
};
struct EpiChan {
    static constexpr bool PERM = true, HOOK = false;
    bf16_t* ABT; bf16_t* ABTC;
    __device__ __forceinline__ void operator()(const Acc& acc, const Unit& u, int wr, int wc, int fr, int fq) const {
        const int b = u.pn / PANB, ip = u.pn % PANB, g = u.pz, cs = u.pm;
        const int tc = wc * 32 + 8 * fq;
        const bool isc = (ip == 0);
        const unsigned ld = isc ? 512u : 16384u;
        bf16_t* base = isc ? ABTC + ((size_t)(b * 1024 + g * 256)) * 512 + cs * 256 + tc : ABT + ((size_t)(b * 1024 + g * 256)) * 16384 + cs * 8192 + (ip - 1) * 256 + tc;
        base += (size_t)(wr * 64 + fr) * ld;
#pragma unroll
        for (int ai = 0; ai < 2; ++ai)
#pragma unroll
            for (int m = 0; m < 4; ++m) { bf16_t* rowp = base + (size_t)((ai * HALF + m * 16) * ld);
#pragma unroll
                for (int bj = 0; bj < 2; ++bj) { const f32x4 v0 = acc[ai][bj][m][0], v1 = acc[ai][bj][m][1];
                    u32x4 w; w.x = cvt_pk_bf16(v0[0], v0[1]); w.y = cvt_pk_bf16(v0[2], v0[3]); w.z = cvt_pk_bf16(v1[0], v1[1]); w.w = cvt_pk_bf16(v1[2], v1[3]);
                    *(u32x4*)(rowp + bj * HALF) = w; }
                asm volatile("" ::: "memory"); }
    }
};
struct EpiGate {
    static constexpr bool PERM = false, HOOK = false;
    bf16_t* RAT;
    __device__ __forceinline__ void operator()(const Acc& acc, const Unit& u, int wr, int wc, int fr, int fq) const {
        const int row0 = u.pm * BM + wr * 64 + fr, c0 = u.pn * 64 + wc * 16 + 4 * fq;
#pragma unroll
        for (int ai = 0; ai < 2; ++ai)
#pragma unroll
            for (int m = 0; m < 4; ++m) { bf16_t* rowp = RAT + (size_t)(row0 + ai * HALF + m * 16) * 16384 + c0;
                f32x4 d[4], iv[4];
#pragma unroll
                for (int i = 0; i < 4; ++i)
#pragma unroll
                    for (int j = 0; j < 4; ++j) { const float g = fminf(fmaxf(acc[ai][i >> 1][m][i & 1][j], -30.f), 30.f); d[i][j] = 1.f + __builtin_amdgcn_exp2f(-1.4426950408889634f * g); iv[i][j] = fast_rcp(d[i][j]); }
#pragma unroll
                for (int i = 0; i < 4; ++i) { const f32x4 v = (i < 3) ? d[i + 1] * iv[i] : iv[3];
                    u32x2 w; w.x = cvt_pk_bf16(v[0], v[1]); w.y = cvt_pk_bf16(v[2], v[3]); *(u32x2*)(rowp + i * DM) = w; }
                asm volatile("" ::: "memory"); }
    }
};
struct EpiMergeH {
    static constexpr bool PERM = false, HOOK = true;
    const bf16_t* RAT; bf16_t* MG;
    __device__ __forceinline__ void scale(Acc& acc, const Unit& u, int i, int wr, int wc, int fr, int fq) const {
        const int row0 = u.pm * BM + wr * 64 + fr, col0 = u.pn * BM + wc * 32 + 4 * fq;
        const bf16_t* base = RAT + (size_t)row0 * 16384 + (size_t)i * DM + col0;
#pragma unroll
        for (int ai = 0; ai < 2; ++ai) { u32x2 sg[4][2][2];
#pragma unroll
            for (int m = 0; m < 4; ++m)
#pragma unroll
                for (int bj = 0; bj < 2; ++bj)
#pragma unroll
                    for (int n = 0; n < 2; ++n) sg[m][bj][n] = *(const u32x2*)(base + (size_t)(ai * HALF + m * 16) * 16384 + bj * HALF + n * 16);
#pragma unroll
            for (int m = 0; m < 4; ++m)
#pragma unroll
                for (int bj = 0; bj < 2; ++bj)
#pragma unroll
                    for (int n = 0; n < 2; ++n) { f32x4 s; s[0] = bf_lo(sg[m][bj][n].x); s[1] = bf_hi(sg[m][bj][n].x); s[2] = bf_lo(sg[m][bj][n].y); s[3] = bf_hi(sg[m][bj][n].y); acc[ai][bj][m][n] *= s; }
            asm volatile("" ::: "memory"); }
    }
    __device__ __forceinline__ void hook(Acc& acc, const Unit& u, int t, int wr, int wc, int fr, int fq) const { if (t > 0 && (t & 15) == 0) scale(acc, u, (t >> 4) - 1, wr, wc, fr, fq); }
    __device__ __forceinline__ void operator()(Acc& acc, const Unit& u, int wr, int wc, int fr, int fq) const {
        scale(acc, u, 3, wr, wc, fr, fq);
        const int row0 = u.pm * BM + wr * 64 + fr, col0 = u.pn * BM + wc * 32 + 4 * fq;
#pragma unroll
        for (int ai = 0; ai < 2; ++ai)
#pragma unroll
            for (int m = 0; m < 4; ++m) { bf16_t* rowp = MG + (size_t)(row0 + ai * HALF + m * 16) * DM + col0;
#pragma unroll
                for (int bj = 0; bj < 2; ++bj)
#pragma unroll
                    for (int n = 0; n < 2; ++n) { const f32x4 v = acc[ai][bj][m][n]; u32x2 w; w.x = cvt_pk_bf16(v[0], v[1]); w.y = cvt_pk_bf16(v[2], v[3]); *(u32x2*)(rowp + bj * HALF + n * 16) = w; }
                asm volatile("" ::: "memory"); }
    }
};
}

namespace att {
constexpr float THR = 8.f;
#define SBAR() __builtin_amdgcn_sched_barrier(0)
__device__ __forceinline__ int crow(int r, int hi) { return (r & 3) + 8 * (r >> 2) + 4 * hi; }
template <int DQK> __device__ __forceinline__ int kswz(int row, int colB) {
    if (DQK == 128) return row * 256 + (colB ^ ((row & 7) << 4));
    else return row * 128 + (colB ^ (((row >> 1) & 7) << 4));
}
template <int DQK, bool MASKED>
__device__ __forceinline__ void partialSM(f32x16& p0, f32x16& p1, float& m_reg, float& mn, float& alpha, bool domask, int dk, int kp0, int hi) {
    constexpr float SCALE = DQK == 128 ? 0.08838834764831845f : 0.125f;
    constexpr float C = SCALE * 1.4426950408889634f;
    if (MASKED && domask) {
#pragma unroll
        for (int r = 0; r < 16; ++r) { const int kk = crow(r, hi); const int d0 = dk + kk, k0 = kp0 + kk, d1 = d0 + 32, k1 = k0 + 32;
            const bool ok0 = (d0 >= -128) & (d0 <= 128) & (k0 >= 0) & (k0 < SEQ), ok1 = (d1 >= -128) & (d1 <= 128) & (k1 >= 0) & (k1 < SEQ);
            p0[r] = ok0 ? p0[r] : -1e30f; p1[r] = ok1 ? p1[r] : -1e30f; }
    }
    float pmax = p0[0];
#pragma unroll
    for (int r = 1; r < 16; ++r) pmax = fmaxf(pmax, p0[r]);
#pragma unroll
    for (int r = 0; r < 16; ++r) pmax = fmaxf(pmax, p1[r]);
    { auto rr = __builtin_amdgcn_permlane32_swap(__float_as_uint(pmax), __float_as_uint(pmax), false, false);
      pmax = fmaxf(__uint_as_float(rr[0]), __uint_as_float(rr[1])); }
    if (__builtin_expect(__all(pmax - m_reg <= THR / SCALE), 1)) { mn = m_reg; alpha = 1.f; }
    else { mn = fmaxf(m_reg, pmax); alpha = __builtin_amdgcn_exp2f((m_reg - mn) * C); m_reg = mn; }
    const float mnC = -mn * C;
#pragma unroll
    for (int r = 0; r < 16; ++r) p0[r] = fmaf(p0[r], C, mnC);
#pragma unroll
    for (int r = 0; r < 16; ++r) p1[r] = fmaf(p1[r], C, mnC);
#pragma unroll
    for (int r = 0; r < 16; ++r) p0[r] = __builtin_amdgcn_exp2f(p0[r]);
}
__device__ __forceinline__ void finishSM(f32x16& p0, f32x16& p1, float alpha, float& l_reg, bf16x8& pa0, bf16x8& pa1, bf16x8& pa2, bf16x8& pa3) {
#pragma unroll
    for (int r = 0; r < 16; ++r) p1[r] = __builtin_amdgcn_exp2f(p1[r]);
    float ps = 0;
#pragma unroll
    for (int r = 0; r < 16; ++r) ps += p0[r];
#pragma unroll
    for (int r = 0; r < 16; ++r) ps += p1[r];
    { auto rr = __builtin_amdgcn_permlane32_swap(__float_as_uint(ps), __float_as_uint(ps), false, false);
      ps = __uint_as_float(rr[0]) + __uint_as_float(rr[1]); }
    l_reg = l_reg * alpha + ps;
#define PK4(P, BASE, OUT) do { unsigned a0 = cvt_pk_bf16(P[BASE + 0], P[BASE + 1]), a1 = cvt_pk_bf16(P[BASE + 2], P[BASE + 3]);   \
    unsigned b0 = cvt_pk_bf16(P[BASE + 4], P[BASE + 5]), b1 = cvt_pk_bf16(P[BASE + 6], P[BASE + 7]);                              \
    auto r0 = __builtin_amdgcn_permlane32_swap(a0, b0, false, false); auto r1 = __builtin_amdgcn_permlane32_swap(a1, b1, false, false); \
    u32x4 w = {r0[0], r1[0], r0[1], r1[1]}; OUT = *reinterpret_cast<bf16x8*>(&w); } while (0)
    PK4(p0, 0, pa0); PK4(p0, 8, pa1); PK4(p1, 0, pa2); PK4(p1, 8, pa3);
#undef PK4
}
template <int DQK>
__device__ __forceinline__ void qkt(f32x16& p0, f32x16& p1, const LAS char* Ks, const bf16x8* qr, int r32, int hi) {
    p0 = f32x16{}; p1 = f32x16{};
#pragma unroll
    for (int d0 = 0; d0 < DQK / 16; ++d0) { const int cb = (d0 * 16 + hi * 8) * 2;
        const bf16x8 b0 = *reinterpret_cast<const LAS bf16x8*>(Ks + kswz<DQK>(r32, cb));
        const bf16x8 b1 = *reinterpret_cast<const LAS bf16x8*>(Ks + kswz<DQK>(32 + r32, cb));
        p0 = __builtin_amdgcn_mfma_f32_32x32x16_bf16(b0, qr[d0], p0, 0, 0, 0);
        p1 = __builtin_amdgcn_mfma_f32_32x32x16_bf16(b1, qr[d0], p1, 0, 0, 0); }
}
__device__ __forceinline__ int v_st(int k, int c) { const int kk = (k & ~0xC) | ((k & 4) << 1) | ((k & 8) >> 1); return ((kk >> 3) * 4 + (c >> 5)) * 512 + ((kk & 7) * 32 + (c & 31)) * 2; }
__device__ __forceinline__ int v_rd_base(int lane) { return ((lane & 3) << 3) | (((lane >> 2) & 3) << 6) | (((lane >> 4) & 1) << 5) | (((lane >> 5) & 1) << 8); }
constexpr int v_rd_off(int d0, int ks, int half) { return d0 * 512 + ks * 4096 + half * 2048; }
template <int OFF> __device__ __forceinline__ s16x4 tr_read(int vb) {
    s16x4 r; asm volatile("ds_read_b64_tr_b16 %0, %1 offset:%2" : "=&v"(r) : "v"(vb), "i"(OFF) : "memory"); return r;
}
template <int D0> __device__ __forceinline__ void pv_one(f32x16& od, int vb, bf16x8 pa0, bf16x8 pa1, bf16x8 pa2, bf16x8 pa3) {
    const s16x4 l0 = tr_read<v_rd_off(D0, 0, 0)>(vb), h0 = tr_read<v_rd_off(D0, 0, 1)>(vb), l1 = tr_read<v_rd_off(D0, 1, 0)>(vb), h1 = tr_read<v_rd_off(D0, 1, 1)>(vb);
    const s16x4 l2 = tr_read<v_rd_off(D0, 2, 0)>(vb), h2 = tr_read<v_rd_off(D0, 2, 1)>(vb), l3 = tr_read<v_rd_off(D0, 3, 0)>(vb), h3 = tr_read<v_rd_off(D0, 3, 1)>(vb);
    asm volatile("s_waitcnt lgkmcnt(0)" ::: "memory"); SBAR();
#define PK(L, H) (bf16x8){L[0], L[1], L[2], L[3], H[0], H[1], H[2], H[3]}
    od = __builtin_amdgcn_mfma_f32_32x32x16_bf16(pa0, PK(l0, h0), od, 0, 0, 0);
    od = __builtin_amdgcn_mfma_f32_32x32x16_bf16(pa1, PK(l1, h1), od, 0, 0, 0);
    od = __builtin_amdgcn_mfma_f32_32x32x16_bf16(pa2, PK(l2, h2), od, 0, 0, 0);
    od = __builtin_amdgcn_mfma_f32_32x32x16_bf16(pa3, PK(l3, h3), od, 0, 0, 0);
#undef PK
}
__device__ __forceinline__ void pv_d0(f32x16* o, int vb, bf16x8 pa0, bf16x8 pa1, bf16x8 pa2, bf16x8 pa3) {
    pv_one<0>(o[0], vb, pa0, pa1, pa2, pa3); pv_one<1>(o[1], vb, pa0, pa1, pa2, pa3); pv_one<2>(o[2], vb, pa0, pa1, pa2, pa3); pv_one<3>(o[3], vb, pa0, pa1, pa2, pa3);
}

template <int DQK, bool MASKED, int LDQ, int LDK, int LDV>
__device__ __forceinline__ void attn_unit(const bf16_t* __restrict__ Qb, const bf16_t* __restrict__ Kb, const bf16_t* __restrict__ Vb,
                                          int NT, int nctx, int loc0, int qpos0, float m_init, float l_init, LAS char* lds, f32x16 (&o)[4]) {
    constexpr int SHM_V = 64 * 128 * 2, SHM_K = 64 * DQK * 2, NQ = DQK / 16;
    int tid_ = threadIdx.x; asm volatile("" : "+v"(tid_));
    const int tid = tid_, wid = __builtin_amdgcn_readfirstlane(tid >> 6), lane = tid & 63, r32 = lane & 31, hi = lane >> 5;
    LAS char* V_lds = lds; LAS char* K_lds = lds + 2 * SHM_V;
    LAS float* ws = (LAS float*)(lds + 2 * SHM_V + 2 * SHM_K) + wid * 64; LAS float* li_l = ws; LAS float* al_l = ws + 32;
    float m_reg = m_init, l_reg = l_init;
#pragma unroll
    for (int d = 0; d < 4; ++d) o[d] = f32x16{};
    bf16x8 qr[NQ];
    const bf16_t* Qw = Qb + (unsigned)((wid * 32 + r32) * LDQ + hi * 8);
#pragma unroll
    for (int d0 = 0; d0 < NQ; ++d0) qr[d0] = *reinterpret_cast<const bf16x8*>(Qw + d0 * 16);
    const int sr = tid >> 4, sc = (tid & 15) * 8, vst0 = v_st(sr, sc), vst1 = v_st(32 + sr, sc);
    const int kr = (DQK == 128) ? sr : (tid >> 3), kc = (DQK == 128) ? sc : (tid & 7) * 8;
    const int kst0 = kswz<DQK>(kr, kc * 2), kst1 = kswz<DQK>(32 + kr, kc * 2);
    const int vb0 = (int)(unsigned)(uintptr_t)V_lds + v_rd_base(lane);
    const int qrel = qpos0 + wid * 32 + r32;
    const unsigned vo = (unsigned)(sr * LDV + sc) * 2u, ko = (unsigned)(kr * LDK + kc) * 2u;
    struct Slot { bf16x8 vs0, vs1, ks0, ks1; } s0, s1;
#define TROW(j) ((!MASKED || (j) < nctx) ? 64 * (j) : (CTXL + min(max(loc0 + 64 * ((j) - nctx), 0), SEQ - 64)))
#define SLOAD(S, j) do { const int rb_ = TROW(j); const char* vp_ = (const char*)Vb + (size_t)rb_ * (LDV * 2); const char* kp_ = (const char*)Kb + (size_t)rb_ * (LDK * 2); \
    S.vs0 = *reinterpret_cast<const bf16x8*>(vp_ + vo); S.vs1 = *reinterpret_cast<const bf16x8*>(vp_ + 32 * LDV * 2 + vo); \
    S.ks0 = *reinterpret_cast<const bf16x8*>(kp_ + ko); if (DQK == 128) S.ks1 = *reinterpret_cast<const bf16x8*>(kp_ + 32 * LDK * 2 + ko); } while (0)
#define SWRITE(b, S) do { *reinterpret_cast<LAS bf16x8*>(V_lds + (b) * SHM_V + vst0) = S.vs0; *reinterpret_cast<LAS bf16x8*>(V_lds + (b) * SHM_V + vst1) = S.vs1; \
    *reinterpret_cast<LAS bf16x8*>(K_lds + (b) * SHM_K + kst0) = S.ks0; if (DQK == 128) *reinterpret_cast<LAS bf16x8*>(K_lds + (b) * SHM_K + kst1) = S.ks1; } while (0)
#define SWAIT() do { if (DQK == 128) asm volatile("s_waitcnt vmcnt(4)" ::: "memory"); else asm volatile("s_waitcnt vmcnt(3)" ::: "memory"); } while (0)
#define RESC(a) do { if (__any((a) < 1.f)) { if (hi == 0) al_l[r32] = (a); asm volatile("s_waitcnt lgkmcnt(0)" ::: "memory"); \
    _Pragma("unroll") for (int d = 0; d < 4; ++d) _Pragma("unroll") for (int r = 0; r < 16; ++r) o[d][r] *= al_l[crow(r, hi)]; } } while (0)
#define PSM(P0, P1, MN, AL, j) partialSM<DQK, MASKED>(P0, P1, m_reg, MN, AL, MASKED && (j) >= nctx, loc0 + 64 * ((j) - nctx) - qrel, loc0 + 64 * ((j) - nctx), hi)
    f32x16 pA0, pA1, pB0, pB1; float mnA, mnB, alA, alB; bf16x8 pa0, pa1, pa2, pa3;
    SLOAD(s0, 0); asm volatile("s_waitcnt vmcnt(0)" ::: "memory"); SWRITE(0, s0); __syncthreads();
    qkt<DQK>(pA0, pA1, K_lds, qr, r32, hi); PSM(pA0, pA1, mnA, alA, 0);
    SLOAD(s1, 1); if (2 < NT) SLOAD(s0, 2);
    SWAIT(); SWRITE(1, s1); __syncthreads();
    for (int j = 1; j + 1 < NT; j += 2) {
        SBAR(); qkt<DQK>(pB0, pB1, K_lds + SHM_K, qr, r32, hi);
        finishSM(pA0, pA1, alA, l_reg, pa0, pa1, pa2, pa3); SBAR();
        SLOAD(s1, j + 2); SBAR();
        pv_d0(o, vb0, pa0, pa1, pa2, pa3); PSM(pB0, pB1, mnB, alB, j);
        __syncthreads(); SWAIT(); SWRITE(0, s0);
        RESC(alB); __syncthreads();
        SBAR(); qkt<DQK>(pA0, pA1, K_lds, qr, r32, hi);
        finishSM(pB0, pB1, alB, l_reg, pa0, pa1, pa2, pa3); SBAR();
        if (j + 3 < NT) SLOAD(s0, j + 3);
        SBAR();
        pv_d0(o, vb0 + SHM_V, pa0, pa1, pa2, pa3); PSM(pA0, pA1, mnA, alA, j + 1);
        __syncthreads(); SWAIT(); SWRITE(1, s1);
        RESC(alA); __syncthreads();
    }
    SBAR(); qkt<DQK>(pB0, pB1, K_lds + SHM_K, qr, r32, hi);
    finishSM(pA0, pA1, alA, l_reg, pa0, pa1, pa2, pa3); SBAR();
    pv_d0(o, vb0, pa0, pa1, pa2, pa3); PSM(pB0, pB1, mnB, alB, NT - 1);
    __syncthreads(); RESC(alB);
    finishSM(pB0, pB1, alB, l_reg, pa0, pa1, pa2, pa3); SBAR();
    pv_d0(o, vb0 + SHM_V, pa0, pa1, pa2, pa3);
    if (hi == 0) li_l[r32] = l_reg;
    asm volatile("s_waitcnt lgkmcnt(0)" ::: "memory");
#pragma unroll
    for (int r = 0; r < 16; ++r) { const float rl = __builtin_amdgcn_rcpf(li_l[crow(r, hi)]);
#pragma unroll
        for (int d = 0; d < 4; ++d) o[d][r] *= rl; }
    __syncthreads();
#undef TROW
#undef SLOAD
#undef SWRITE
#undef SWAIT
#undef RESC
#undef PSM
}
}

#define XB_TMO      128
#define XB_XCNT(j)  (256  + 64 * (j))
#define XB_XSUB(j)  (1280 + 64 * (j))
#define XB_XGEN(j)  (2304 + 64 * (j))
#define XB_TOP      3328
#define XB_TOPGEN   3392
#define XCD_BAR_WORDS 3456
#define XB_SPIN_CAP (1u << 18)
__device__ __forceinline__ unsigned xb_ld(unsigned* p)              { return __hip_atomic_load(p, __ATOMIC_RELAXED, __HIP_MEMORY_SCOPE_AGENT); }
__device__ __forceinline__ unsigned xb_add(unsigned* p, unsigned v) { return __hip_atomic_fetch_add(p, v, __ATOMIC_RELAXED, __HIP_MEMORY_SCOPE_AGENT); }
__device__ __forceinline__ unsigned xb_xcc_id() { return (unsigned)__builtin_amdgcn_s_getreg((3 << 11) | 20) & 0xFu; }
#define XB_SPIN(cond, bar) do { unsigned _sp = 0; while (cond) { __builtin_amdgcn_s_sleep(1); \
    if ((++_sp & 255u) == 0u) { if (xb_ld(&(bar)[XB_TMO])) break; if (_sp > XB_SPIN_CAP) { atomicAdd(&(bar)[XB_TMO], 1u); break; } } } } while (0)
struct XcdBarrier { unsigned* bar; unsigned x; volatile LAS unsigned* st; };
__device__ __forceinline__ XcdBarrier xcd_barrier_post(unsigned* bar, volatile LAS unsigned* st) {
    XcdBarrier b; b.bar = bar; b.x = xb_xcc_id(); b.st = st;
    if (threadIdx.x == 0) (void)xb_add(&bar[XB_XCNT(b.x)], 1u);
    return b;
}
__device__ __forceinline__ void xcd_barrier_complete(unsigned* bar, unsigned x, unsigned& nloc, unsigned& nx) {
    const unsigned G = gridDim.x * gridDim.y * gridDim.z;
    unsigned sum, cnt, mine, sp = 0u;
    for (;;) {
        sum = 0u; cnt = 0u; mine = 0u;
#pragma unroll
        for (unsigned j = 0; j < 16; ++j) { const unsigned c = xb_ld(&bar[XB_XCNT(j)]); sum += c; cnt += (c > 0u) ? 1u : 0u; mine = (j == x) ? c : mine; }
        if (sum == G) break;
        __builtin_amdgcn_s_sleep(1);
        if ((++sp & 255u) == 0u) { if (xb_ld(&bar[XB_TMO])) break; if (sp > XB_SPIN_CAP) { atomicAdd(&bar[XB_TMO], 1u); break; } }
    }
    nloc = mine > 0u ? mine : 1u; nx = cnt > 0u ? cnt : 1u;
}
__device__ __forceinline__ void xcd_barrier(const XcdBarrier& b) {
    asm volatile("s_waitcnt vmcnt(0)" ::: "memory");
    __syncthreads();
    if (threadIdx.x == 0) {
        unsigned* bar = b.bar;
        __builtin_amdgcn_s_waitcnt(0);
        unsigned nloc = b.st[0], nx = b.st[1];
        if (nloc == 0u) { xcd_barrier_complete(bar, b.x, nloc, nx); b.st[0] = nloc; b.st[1] = nx; }
        const unsigned old = xb_add(&bar[XB_XSUB(b.x)], 1u);
        const unsigned gen = old / nloc;
        if (old + 1u == (gen + 1u) * nloc) {
            __builtin_amdgcn_fence(__ATOMIC_RELEASE, "agent");
            asm volatile("s_waitcnt vmcnt(0)" ::: "memory");
            const unsigned og = xb_add(&bar[XB_TOP], 1u);
            const unsigned tg = og / nx;
            if (og + 1u == (tg + 1u) * nx) xb_add(&bar[XB_TOPGEN], 1u);
            else XB_SPIN(xb_ld(&bar[XB_TOPGEN]) == tg, bar);
            __builtin_amdgcn_fence(__ATOMIC_ACQUIRE, "agent");
            xb_add(&bar[XB_XGEN(b.x)], 1u);
            asm volatile("s_waitcnt vmcnt(0)" ::: "memory");
        } else {
            XB_SPIN(xb_ld(&bar[XB_XGEN(b.x)]) == gen, bar);
            __builtin_amdgcn_fence(__ATOMIC_ACQUIRE, "agent");
            asm volatile("s_waitcnt vmcnt(0)" ::: "memory");
        }
    }
    __syncthreads();
}

struct Args { const float* in[22]; float* out; unsigned char* ws; int ph_lo, ph_hi; };
__device__ __forceinline__ const float* inp(LAS unsigned char* lds, int k) {
    volatile LAS unsigned* p = (volatile LAS unsigned*)(lds + PTR_OFF) + 2 * k;
    const unsigned lo = __builtin_amdgcn_readfirstlane(p[0]), hi = __builtin_amdgcn_readfirstlane(p[1]);
    return (const float*)(const GAS float*)(((unsigned long long)hi << 32) | lo);
}

__device__ __forceinline__ float wave_sum(float v) {
#pragma unroll
    for (int o = 1; o < 64; o <<= 1) v += __shfl_xor(v, o);
    return v;
}
template <bool GATEMAP = false>
__device__ __forceinline__ void tr_item(const float* __restrict__ W, int N, bf16_t* __restrict__ WT, int ldd, int k0, int n0, int drow0, int dcol0, LAS unsigned* scr, int lane) {
    const float* src = W + (size_t)k0 * N + n0 + lane;
#pragma unroll 8
    for (int kk = 0; kk < 64; ++kk) { const float a = src[(size_t)(2 * kk) * N], b = src[(size_t)(2 * kk + 1) * N]; scr[lane * 65 + kk] = cvt_pk_bf16(a, b); }
    LDS_WAIT(); asm volatile("" ::: "memory");
    const int q = lane & 15;
#pragma unroll 4
    for (int i = 0; i < 16; ++i) { const int n = 4 * i + (lane >> 4); const LAS unsigned* s = scr + n * 65 + 4 * q;
        u32x4 o; o.x = s[0]; o.y = s[1]; o.z = s[2]; o.w = s[3];
        const int dr = GATEMAP ? drow0 + 32 * (n >> 4) + (n & 15) : drow0 + n;
        *(u32x4*)(WT + (size_t)dr * ldd + dcol0 + 8 * q) = o; }
    LDS_WAIT(); asm volatile("" ::: "memory");
}

__device__ __forceinline__ void prologue_a(unsigned char* ws, LAS unsigned char* lds, int gw, int NGW, int wave, int lane) {
    LAS unsigned* scr = (LAS unsigned*)(lds + wave * 16640);
    constexpr int I13 = 32 * 160, I2 = 40 * 64, IIN = 32 * 140, IB = 8 * 64, IG = 2 * 256, IO = 32 * 64;
    constexpr int IL = 2 * I13 + 2 * I2 + IIN + 4 * IB + IG + IO;
    const float* p8 = inp(lds, 8); const float* p9 = inp(lds, 9); const float* p10 = inp(lds, 10); const float* p19 = inp(lds, 19); const float* p20 = inp(lds, 20); const float* p21 = inp(lds, 21);
    for (int it = gw; it < DEPTH * IL; it += NGW) {
        const int l = it / IL; int r = it % IL; unsigned char* wl = ws + WS_W + (size_t)l * WL_SIZE;
        if (r < 2 * I13) { const int k = r / I13; r %= I13; const int kb = r / 160, nb = r % 160, n0 = nb * 64;
            const int drow0 = n0 < DFF ? 256 * (n0 / 128) + (n0 % 128) : 256 * ((n0 - DFF) / 128) + 128 + ((n0 - DFF) % 128);
            tr_item(p8 + (size_t)(l * 2 + k) * DM * 2 * DFF, 2 * DFF, (bf16_t*)(wl + WL_W13) + (size_t)k * 2 * DFF * DM, DM, kb * 128, n0, drow0, kb * 128, scr, lane); continue; }
        r -= 2 * I13;
        if (r < 2 * I2) { const int k = r / I2; r %= I2; const int kb = r / 64, nb = r % 64;
            tr_item(p9 + (size_t)(l * 2 + k) * DFF * DM, DM, (bf16_t*)(wl + WL_W2) + (size_t)k * DM * DFF, DFF, kb * 128, nb * 64, nb * 64, kb * 128, scr, lane); continue; }
        r -= 2 * I2;
        if (r < IIN) { const int kb = r / 140, nb = r % 140;
            tr_item(p10 + (size_t)l * DM * NIN, NIN, (bf16_t*)(wl + WL_WIN), DM, kb * 128, nb * 64, nb * 64, kb * 128, scr, lane); continue; }
        r -= IIN;
        if (r < 4 * IB) { const int i = r / IB; r %= IB; const int kb = r / 64, nb = r % 64;
            tr_item(p19 + (size_t)(l * 4 + i) * 1024 * DM, DM, (bf16_t*)(wl + WL_WB), DM, kb * 128, nb * 64, nb * 64, i * 1024 + kb * 128, scr, lane); continue; }
        r -= 4 * IB;
        if (r < IG) { const int kb = r / 256, nb = r % 256;
            const int gi = nb >> 6, c0 = (nb & 63) * 64;
            tr_item<true>(p20 + (size_t)l * 256 * 16384, 16384, (bf16_t*)(wl + WL_GATE), 256, kb * 128, nb * 64, 256 * (c0 >> 6) + 128 * (gi >> 1) + 16 * (gi & 1), kb * 128, scr, lane); continue; }
        r -= IG;
        { const int kb = r / 64, nb = r % 64;
            tr_item(p21 + (size_t)l * DM * DM, DM, (bf16_t*)(wl + WL_WO), DM, kb * 128, nb * 64, nb * 64, kb * 128, scr, lane); }
    }
    const long gt = (long)gw * 64 + lane, NGT = (long)NGW * 64;
    { bf16_t* cs = (bf16_t*)(ws + WS_CS);
      for (long idx = gt; idx < (long)SEQ * 2048; idx += NGT) { const int k = (int)(idx >> 11), c8 = (int)(idx & 2047), tp = c8 * 8, part = tp >> 13, t0 = tp & 8191; float v[8];
#pragma unroll
          for (int e = 0; e < 8; ++e) { const float x = (float)((k * (t0 + e)) & 8191) * (1.f / 8192.f); v[e] = part ? __builtin_amdgcn_sinf(x) : __builtin_amdgcn_cosf(x); }
          u32x4 w; w.x = cvt_pk_bf16(v[0], v[1]); w.y = cvt_pk_bf16(v[2], v[3]); w.z = cvt_pk_bf16(v[4], v[5]); w.w = cvt_pk_bf16(v[6], v[7]);
          *(u32x4*)(cs + idx * 8) = w; } }
    { bf16_t* ct = (bf16_t*)(ws + WS_CSCT); bf16_t* cx = (bf16_t*)(ws + WS_CSCTX);
      for (long idx = gt; idx < 512 * 256; idx += NGT) { const int m = (int)(idx >> 8), c = (int)(idx & 255); const float x = (float)(((m & 255) * c) & 255) * (1.f / 256.f);
          const float v = (m < 256) ? __builtin_amdgcn_cosf(x) : -__builtin_amdgcn_sinf(x); ct[idx] = (bf16_t)(cvt_pk_bf16(v, 0.f) & 0xffffu); }
      for (long idx = gt; idx < 256 * 512; idx += NGT) { const int k = (int)(idx >> 9), tp = (int)(idx & 511); const float x = (float)((k * (tp & 255)) & 255) * (1.f / 256.f);
          const float v = (tp < 256) ? __builtin_amdgcn_cosf(x) : __builtin_amdgcn_sinf(x); cx[idx] = (bf16_t)(cvt_pk_bf16(v, 0.f) & 0xffffu); } }
    { float* rp = (float*)(ws + WS_ROPE);
      for (long idx = gt; idx < 128 * 32; idx += NGT) { const int pos = (int)(idx >> 5), i = (int)(idx & 31); const float inv = exp2f(-(float)(2 * i) * (1.f / 64.f) * 13.287712379549449f);
          float rev = (float)pos * inv * 0.15915494309189535f; rev -= floorf(rev); rp[idx] = __builtin_amdgcn_cosf(rev); rp[4096 + idx] = __builtin_amdgcn_sinf(rev); }
      for (long idx = gt; idx < 128 * 16; idx += NGT) { const int pos = (int)(idx >> 4), i = (int)(idx & 15); const float inv = exp2f(-(float)(2 * i) * (1.f / 32.f) * 13.287712379549449f);
          float rev = (float)pos * inv * 0.15915494309189535f; rev -= floorf(rev); rp[8192 + idx] = __builtin_amdgcn_cosf(rev); rp[8192 + 2048 + idx] = __builtin_amdgcn_sinf(rev); } }
    { float* xs = (float*)(ws + WS_XS); const float* pctx = inp(lds, 2); const float* px = inp(lds, 0);
      for (int r = gw; r < T; r += NGW) { const int b = r / TB, i = r % TB; const float* src = (i < CTXL) ? pctx + (size_t)(b * CTXL + i) * DM : px + (size_t)(b * SEQ + i - CTXL) * DM;
          const f32x4* s4 = (const f32x4*)src + lane; f32x4* d4 = (f32x4*)(xs + (size_t)r * DM) + lane;
#pragma unroll
          for (int j = 0; j < 16; ++j) d4[64 * j] = s4[64 * j]; } }
    { float* t1 = (float*)(ws + WS_T1P); const float* pc = inp(lds, 1); const float* pcc = inp(lds, 3); const float* pdn = inp(lds, 5);
      for (int it = gw; it < DEPTH * 64; it += NGW) { const int l = it >> 6, ch = it & 63; f32x4 acc0 = {0, 0, 0, 0}, acc1 = acc0, acc2 = acc0;
          const float* dn = pdn + ((size_t)l * DM + ch * 64) * 256 + 4 * lane;
          for (int d = 0; d < 64; ++d) { const int dd = ch * 64 + d; const f32x4 row = *(const f32x4*)(dn + (size_t)d * 256);
              const float c0 = pc[dd], c1 = pc[DM + dd], c2 = pcc[dd];
              acc0 += row * (c0 / (1.f + __expf(-c0))); acc1 += row * (c1 / (1.f + __expf(-c1))); acc2 += row * (c2 / (1.f + __expf(-c2))); }
          float* o = t1 + ((size_t)(l * 64 + ch) * 3) * 256 + 4 * lane; *(f32x4*)o = acc0; *(f32x4*)(o + 256) = acc1; *(f32x4*)(o + 512) = acc2; } }
    if (gw == 0) { float* lm = (float*)(ws + WS_LAM); const float* pdl = inp(lds, 17);
        for (int l = 0; l < DEPTH; ++l) { const float* dl = pdl + l * 256; const float s1 = wave_sum(dl[lane] * dl[64 + lane]), s2 = wave_sum(dl[128 + lane] * dl[192 + lane]);
            const float li = 0.8f - 0.6f * expf(-0.3f * (float)l); if (lane == 0) { lm[l] = expf(s1) - expf(s2) + li; lm[4 + l] = 1.f - li; } } }
}
__device__ __forceinline__ void prologue_b(unsigned char* ws, LAS unsigned char* lds, int gw, int NGW, int wave, int lane) {
    LAS float* tl = (LAS float*)(lds + wave * 4096);
    const float* t1 = (const float*)(ws + WS_T1P); float* mod = (float*)(ws + WS_MOD); const float* pb7 = inp(lds, 7); const float* pup = inp(lds, 6);
    for (int it = gw; it < DEPTH * 144; it += NGW) { const int l = it / 144, n0 = (it % 144) * 256 + 4 * lane;
        f32x4 t0 = {0, 0, 0, 0}, t1v = t0, t2 = t0;
        for (int ch = 0; ch < 64; ++ch) { const float* p = t1 + ((size_t)(l * 64 + ch) * 3) * 256 + 4 * lane; t0 += *(const f32x4*)p; t1v += *(const f32x4*)(p + 256); t2 += *(const f32x4*)(p + 512); }
        *(LAS f32x4*)(tl + 4 * lane) = t0; *(LAS f32x4*)(tl + 256 + 4 * lane) = t1v; *(LAS f32x4*)(tl + 512 + 4 * lane) = t2;
        LDS_WAIT(); asm volatile("" ::: "memory");
        const f32x4 bb = *(const f32x4*)(pb7 + (size_t)l * NMOD * DM + n0); f32x4 acc0 = bb, acc1 = bb, acc2 = bb;
        const float* up = pup + (size_t)l * 256 * NMOD * DM + n0;
#pragma unroll 4
        for (int j = 0; j < 256; ++j) { const f32x4 row = *(const f32x4*)(up + (size_t)j * NMOD * DM); acc0 += row * tl[j]; acc1 += row * tl[256 + j]; acc2 += row * tl[512 + j]; }
        float* o = mod + (size_t)(l * 3) * NMOD * DM + n0; *(f32x4*)o = acc0; *(f32x4*)(o + NMOD * DM) = acc1; *(f32x4*)(o + 2 * NMOD * DM) = acc2;
        LDS_WAIT(); asm volatile("" ::: "memory"); }
}
__device__ __forceinline__ void norm_phase(unsigned char* ws, LAS unsigned char* lds, int l, int k, int gw, int NGW, int tid, int lane) {
    asm volatile("" : "+v"(lane), "+v"(tid));
    LAS float* gp = (LAS float*)lds; LAS float* sh = gp + 3 * DM;
    const float* mod = (const float*)(ws + WS_MOD) + (size_t)(l * 3) * NMOD * DM; const float* g = inp(lds, 4) + (size_t)(l * 3 + k) * DM;
    for (int i = tid; i < 3 * DM; i += NTHREADS) { const int v = i / DM, c = i % DM; gp[i] = g[c] * (1.f + mod[(size_t)v * NMOD * DM + (3 * k + 1) * DM + c]); sh[i] = mod[(size_t)v * NMOD * DM + (3 * k) * DM + c]; }
    __syncthreads();
    const float* xs = (const float*)(ws + WS_XS); bf16_t* H = (bf16_t*)(ws + WS_H);
    for (int r = gw; r < T; r += NGW) { const int b = r / TB, i = r % TB, v = (i < CTXL) ? 2 : b;
        const f32x4* xr = (const f32x4*)(xs + (size_t)r * DM) + lane; f32x4 x[16]; float s = 0.f;
#pragma unroll
        for (int j = 0; j < 16; ++j) { x[j] = xr[64 * j]; s += (x[j][0] * x[j][0] + x[j][1] * x[j][1]) + (x[j][2] * x[j][2] + x[j][3] * x[j][3]); }
        const float rstd = 1.f / sqrtf(wave_sum(s) * (1.f / DM) + EPS);
        u32x2* o = (u32x2*)(H + (size_t)r * DM) + lane;
#pragma unroll
        for (int j = 0; j < 16; ++j) { const f32x4 gg = *(const LAS f32x4*)(gp + v * DM + 4 * lane + 256 * j), ss = *(const LAS f32x4*)(sh + v * DM + 4 * lane + 256 * j);
            const f32x4 y = x[j] * rstd * gg + ss; u32x2 w; w.x = cvt_pk_bf16(y[0], y[1]); w.y = cvt_pk_bf16(y[2], y[3]); o[64 * j] = w; } }
    __syncthreads();
}
__device__ __forceinline__ void ld16(const bf16_t* p, float (&x)[16]) { const u32x4 a = *(const u32x4*)p, b = *(const u32x4*)(p + 8);
    x[0] = bf_lo(a.x); x[1] = bf_hi(a.x); x[2] = bf_lo(a.y); x[3] = bf_hi(a.y); x[4] = bf_lo(a.z); x[5] = bf_hi(a.z); x[6] = bf_lo(a.w); x[7] = bf_hi(a.w);
    x[8] = bf_lo(b.x); x[9] = bf_hi(b.x); x[10] = bf_lo(b.y); x[11] = bf_hi(b.y); x[12] = bf_lo(b.z); x[13] = bf_hi(b.z); x[14] = bf_lo(b.w); x[15] = bf_hi(b.w); }
__device__ __forceinline__ void st16(bf16_t* p, const float (&x)[16]) { u32x4 a, b;
    a.x = cvt_pk_bf16(x[0], x[1]); a.y = cvt_pk_bf16(x[2], x[3]); a.z = cvt_pk_bf16(x[4], x[5]); a.w = cvt_pk_bf16(x[6], x[7]);
    b.x = cvt_pk_bf16(x[8], x[9]); b.y = cvt_pk_bf16(x[10], x[11]); b.z = cvt_pk_bf16(x[12], x[13]); b.w = cvt_pk_bf16(x[14], x[15]); *(u32x4*)p = a; *(u32x4*)(p + 8) = b; }
template <int HD>
__device__ __forceinline__ void normrope(float (&x)[16], int lane, const float* __restrict__ gain, bool rope, int rowpos, int colpos, const float* __restrict__ rp) {
    float s = 0.f;
#pragma unroll
    for (int e = 0; e < 16; ++e) s += x[e] * x[e];
    s += __shfl_xor(s, 1); s += __shfl_xor(s, 2); if (HD == 128) s += __shfl_xor(s, 4);
    const float rstd = 1.f / sqrtf(s * (1.f / HD) + EPS);
    const int j = lane & (HD / 16 - 1);
#pragma unroll
    for (int e = 0; e < 16; ++e) x[e] = x[e] * rstd * gain[j * 16 + e];
    constexpr int PX = (HD == 128) ? 2 : 1;
    float y[16];
#pragma unroll
    for (int e = 0; e < 16; ++e) y[e] = __shfl_xor(x[e], PX);
    if (rope) {
        const int part = (HD == 128) ? (j >> 2) : (j >> 1), role = (HD == 128) ? ((j >> 1) & 1) : (j & 1), fb = (HD == 128) ? 16 * (j & 1) : 0, pos = part ? colpos : rowpos;
        const float* ct = rp + ((HD == 128) ? 0 : 8192) + pos * (HD / 4) + fb; const float* st = ct + ((HD == 128) ? 4096 : 2048);
#pragma unroll
        for (int e = 0; e < 16; ++e) { const float c = ct[e], sn = st[e]; x[e] = role ? (x[e] * c + y[e] * sn) : (x[e] * c - y[e] * sn); }
    }
}
__device__ __forceinline__ void p6_rows(unsigned char* ws, LAS unsigned char* lds, int l, int gw, int NGW, int lane) {
    asm volatile("" : "+v"(lane));
    const bf16_t* PC = (const bf16_t*)(ws + WS_PIECES); const float* rp = (const float*)(ws + WS_ROPE);
    bf16_t* QS = (bf16_t*)(ws + WS_QS); bf16_t* KS = (bf16_t*)(ws + WS_KS); bf16_t* QD = (bf16_t*)(ws + WS_QD); bf16_t* KD = (bf16_t*)(ws + WS_KD); bf16_t* OB = (bf16_t*)(ws + WS_OB);
    const float* gsq = inp(lds, 12) + l * 128; const float* gsk = inp(lds, 13) + l * 128; const float* gdq = inp(lds, 15) + l * 64; const float* gdk = inp(lds, 16) + l * 64; const float* cw = inp(lds, 11) + (size_t)l * 3 * 1024;
    for (int r = gw; r < T; r += NGW) { const int i = r % TB; const bool lat = i >= CTXL; const int t = i - CTXL, rowpos = (t >> 6) & 127, colpos = t & 63;
        const bf16_t* P = PC + (size_t)r * NIN; float x[16];
        ld16(P + C_SQ + 16 * lane, x); normrope<128>(x, lane, gsq, lat, rowpos, colpos, rp); st16(QS + (size_t)r * 1024 + 16 * lane, x);
        ld16(P + C_SK + 16 * (lane & 15), x); normrope<128>(x, lane, gsk, lat, rowpos, colpos, rp); if (lane < 16) st16(KS + (size_t)r * 256 + 16 * lane, x);
        ld16(P + C_DQ + 16 * lane, x); normrope<64>(x, lane, gdq, lat, rowpos, colpos, rp); st16(QD + (size_t)r * 1024 + 16 * lane, x);
        ld16(P + C_DK + 16 * lane, x); normrope<64>(x, lane, gdk, lat, rowpos, colpos, rp); st16(KD + (size_t)r * 1024 + 16 * lane, x);
        { const int seg_lo = lat ? CTXL : 0, seg_hi = lat ? TB : CTXL; float gc[16], vv[16], y[16];
          ld16(P + C_CONVC + 16 * lane, gc); ld16(P + C_CONVV + 16 * lane, vv);
#pragma unroll
          for (int e = 0; e < 16; ++e) y[e] = gc[e] * vv[e] * cw[1024 + 16 * lane + e];
          if (i - 1 >= seg_lo) { ld16(P - NIN + C_CONVC + 16 * lane, gc); ld16(P - NIN + C_CONVV + 16 * lane, vv);
#pragma unroll
              for (int e = 0; e < 16; ++e) y[e] += gc[e] * vv[e] * cw[16 * lane + e]; }
          if (i + 1 < seg_hi) { ld16(P + NIN + C_CONVC + 16 * lane, gc); ld16(P + NIN + C_CONVV + 16 * lane, vv);
#pragma unroll
              for (int e = 0; e < 16; ++e) y[e] += gc[e] * vv[e] * cw[2048 + 16 * lane + e]; }
          ld16(P + C_CONVB + 16 * lane, gc);
#pragma unroll
          for (int e = 0; e < 16; ++e) y[e] *= gc[e];
          st16(OB + (size_t)r * DM + 1024 + 16 * lane, y); }
    }
}

constexpr int PH_PER_LAYER = 12, N_PHASES = 2 + DEPTH * PH_PER_LAYER;
__global__ void __launch_bounds__(NTHREADS, 2) fwd_kernel(Args args) {
    extern __shared__ __attribute__((aligned(16))) unsigned char lds_raw[];
    LAS unsigned char* lds = (LAS unsigned char*)lds_raw;
    volatile LAS unsigned* MISC = (volatile LAS unsigned*)(lds + MISC_OFF);
    const int tid = threadIdx.x, lane = tid & 63, wave = __builtin_amdgcn_readfirstlane(tid >> 6);
    const int G = gridDim.x, bx = blockIdx.x;
    const int vcu = (G % 8 == 0) ? (bx % 8) * (G / 8) + bx / 8 : bx;
    const int gw = vcu * NWAVES + wave, NGW = G * NWAVES;
    unsigned char* ws = args.ws;
    unsigned* ctl = (unsigned*)(ws + WS_CTL);
    for (int u = tid; u < 64; u += NTHREADS) MISC[u] = 0u;
    if (tid < 22) ((LAS unsigned long long*)(lds + PTR_OFF))[tid] = (unsigned long long)(uintptr_t)args.in[tid];
    __syncthreads();
    XcdBarrier bar; bar.bar = ctl + CW_BAR; bar.x = 0; bar.st = nullptr;
    if (!MK_PER_PHASE) bar = xcd_barrier_post(ctl + CW_BAR, MISC + 8);
    const int lo = args.ph_lo, hi = args.ph_hi;
#ifndef ONLY_SITE
#define ONLY_SITE -1
#endif
#define SITE(s) (ONLY_SITE < 0 || ONLY_SITE == (s))
#ifndef ONLY_SUB
#define ONLY_SUB -1
#endif
#define SUB(s) (ONLY_SUB < 0 || ONLY_SUB == (s))
#ifndef REP_SITE
#define REP_SITE -1
#endif
#ifndef REP_SUB
#define REP_SUB -1
#endif
#define REPS(n) for (int rep_ = 0; rep_ < ((REP_SITE == (n) && REP_SUB < 0) ? 2 : 1); ++rep_)
#define REPSUB(n, q) for (int rep_ = 0; rep_ < ((REP_SITE == (n) && REP_SUB == (q)) ? 2 : 1); ++rep_)
#define IN(k) (lo <= (k) && (k) < hi)
#define SEAM(k) do { if (IN(k) && IN((k) + 1)) { if (MK_PER_PHASE) { if (tid == 0) __hip_atomic_store(ctl + 1, 0xBAD00000u | (unsigned)(k), RLX_AGENT); } else xcd_barrier(bar); } } while (0)

    if (SITE(0) && IN(0)) REPS(0) { prologue_a(ws, lds, gw, NGW, wave, lane); } SEAM(0);
    if (SITE(1) && IN(1)) REPS(1) { prologue_b(ws, lds, gw, NGW, wave, lane); } SEAM(1);

#define H_ ((bf16_t*)(ws + WS_H))
#define ACT_ ((bf16_t*)(ws + WS_ACT))
#define PIECES_ ((bf16_t*)(ws + WS_PIECES))
#define XS_ ((float*)(ws + WS_XS))
#define OB_ ((bf16_t*)(ws + WS_OB))
#define SIG_ ((bf16_t*)(ws + WS_SIG))
#define MG_ ((bf16_t*)(ws + WS_MG))
#define WL_ (ws + WS_W + (size_t)l * WL_SIZE)
#define MODL_ ((const float*)(ws + WS_MOD) + (size_t)(l * 3) * NMOD * DM)
    for (int it = 0; it < 2 * DEPTH; ++it) {
        const int l = it >> 1, hf = it & 1, kidx = hf ? 2 : 0, pb = 2 + PH_PER_LAYER * l + (hf ? 9 : 0);
        if (SITE(2) && IN(pb + 0)) REPS(2) { norm_phase(ws, lds, l, kidx, gw, NGW, tid, lane); } SEAM(pb + 0);
        if (SITE(3) && IN(pb + 1)) REPS(3) {
            pg8::Gemm g{H_, (const bf16_t*)(WL_ + WL_W13) + (size_t)hf * 2 * DFF * DM, DM, DM, DM, 0, 0}; pg8::Order S; S.init(T / 256, 2 * DFF / 256, 1, G, bx, 1);
            pg8::EpiSwiGLU E{ACT_, DFF};
            pg8::gemm_phase<pg8::EpiSwiGLU, true, true>(lds, g, S, E);
        } SEAM(pb + 1);
        if (SITE(4) && IN(pb + 2)) {
            pg8::Gemm g{ACT_, (const bf16_t*)(WL_ + WL_W2) + (size_t)hf * DM * DFF, DFF, DFF, DFF, 0, 0}; pg8::Order S; S.init(T / 256, DM / 256, 1, G, bx, 1);
            pg8::EpiResid<true> E{XS_, MODL_ + (size_t)(kidx * 3 + 2) * DM, args.out, (it == 2 * DEPTH - 1) ? 1 : 0};
            pg8::gemm_phase<pg8::EpiResid<true>, true, true>(lds, g, S, E);
        } SEAM(pb + 2);
        if (hf) continue;
        const int mb = pb + 3;
        if (SITE(5) && IN(mb + 0)) REPS(2) { norm_phase(ws, lds, l, 1, gw, NGW, tid, lane); } SEAM(mb + 0);
        if (SITE(6) && IN(mb + 1)) REPS(6) {
            pg8::Gemm g{H_, (const bf16_t*)(WL_ + WL_WIN), DM, DM, DM, 0, 0}; pg8::Order S; S.init(T / 256, NIN / 256, 1, G, bx, 1);
            pg8::EpiBf16 E{PIECES_, NIN, 0, 0, 1.f};
            pg8::gemm_phase<pg8::EpiBf16, true, true>(lds, g, S, E);
        } SEAM(mb + 1);
        if (SITE(7) && IN(mb + 2)) REPS(7) {
            if (SUB(0)) REPSUB(7, 0) {
                pg8::Gemm g{(const bf16_t*)(ws + WS_CSCT), PIECES_ + C_FOUR, 256, 256, NIN, 0, 256}; pg8::Order S; S.init(2, T / 256, 4, G, bx, 1);
                pg8::EpiChan E{(bf16_t*)(ws + WS_ABT), (bf16_t*)(ws + WS_ABTC)};
                pg8::gemm_phase<pg8::EpiChan, true, true>(lds, g, S, E);
            }
            if (SUB(1)) REPSUB(7, 1) {
                pg8::Gemm g{PIECES_ + C_Z, (const bf16_t*)(WL_ + WL_GATE), 256, NIN, 256, 0, 0}; pg8::Order S; S.init(T / 256, 16384 / 256, 1, G, bx, 1);
                pg8::EpiGate E{SIG_};
                pg8::gemm_phase<pg8::EpiGate, true, true>(lds, g, S, E);
            }
            if (SUB(2)) REPSUB(7, 2) p6_rows(ws, lds, l, gw, NGW, lane);
        } SEAM(mb + 2);
        if (SITE(8) && IN(mb + 3)) REPS(8) {
            if (SUB(0)) REPSUB(8, 0) {
                pg8::Gemm g{(const bf16_t*)(ws + WS_CS), (const bf16_t*)(ws + WS_ABT), 16384, 16384, 16384, 0, (long)1024 * 16384}; pg8::Order S; S.init(SEQ / 256, 4, 2, G, bx, 1);
                pg8::EpiBf16 E{OB_, DM, CTXL, TB, 6.9053396600248786e-4f};
                pg8::gemm_phase<pg8::EpiBf16, true, true>(lds, g, S, E);
            }
            if (SUB(1)) {
                pg8::Gemm g{(const bf16_t*)(ws + WS_CSCTX), (const bf16_t*)(ws + WS_ABTC), 512, 512, 512, 0, (long)1024 * 512}; pg8::Order S; S.init(1, 4, 2, G, bx, 1);
                pg8::EpiBf16 E{OB_, DM, 0, TB, 1.f / 256.f};
                pg8::gemm_phase<pg8::EpiBf16, true, true>(lds, g, S, E);
            }
            __syncthreads();
            const int wid = wave;
            const float* lamp = (const float*)(ws + WS_LAM); const float lam = lamp[l], oml = lamp[4 + l];
            if (SUB(2)) REPSUB(8, 2) for (int u = bx; u < 512 + 16; u += G) {
                int b, h, q0, NT;
                if (u < 512) { b = u >> 8; h = (u >> 5) & 7; q0 = CTXL + (u & 31) * 256; NT = TB / 64; } else { const int v = u - 512; b = v >> 3; h = v & 7; q0 = 0; NT = CTXL / 64; }
                const size_t rb = (size_t)b * TB; float* O1 = (float*)(ws + WS_O1);
                for (int c = 0; c < 2; ++c) {
                    f32x16 o[4];
                    att::attn_unit<64, false, 1024, 1024, NIN>((const bf16_t*)(ws + WS_QD) + (rb + q0) * 1024 + (2 * h + c) * 64, (const bf16_t*)(ws + WS_KD) + rb * 1024 + (2 * h + c) * 64,
                                              (const bf16_t*)(ws + WS_PIECES) + rb * NIN + C_DV + h * 128, NT, 0, 0, 0, -1e30f, 0.f, (LAS char*)lds, o);
                    int ln = lane; asm volatile("" : "+v"(ln));
                    const int r32 = ln & 31, hi5 = ln >> 5;
                    float* O1b = O1 + (rb + q0 + wid * 32) * 1024 + h * 128;
                    const unsigned lo1 = (unsigned)(4 * hi5 * 1024 + r32);
                    if (c == 0) {
#pragma unroll
                        for (int r = 0; r < 16; ++r) { float* p = O1b + ((r & 3) + 8 * (r >> 2)) * 1024 + lo1;
#pragma unroll
                            for (int d = 0; d < 4; ++d) p[d * 32] = o[d][r];
                            asm volatile("" ::: "memory"); }
                    } else {
                        const float* sub = inp(lds, 18) + l * 128; float sg[4];
#pragma unroll
                        for (int d = 0; d < 4; ++d) sg[d] = sub[d * 32 + r32] * oml;
                        bf16_t* OBb = (bf16_t*)(ws + WS_OB) + (rb + q0 + wid * 32) * DM + 3072 + h * 128;
                        const unsigned lo2 = (unsigned)(4 * hi5 * DM + r32);
#pragma unroll
                        for (int r = 0; r < 16; ++r) { const float* p = O1b + ((r & 3) + 8 * (r >> 2)) * 1024 + lo1; float dv[4], ss = 0.f;
#pragma unroll
                            for (int d = 0; d < 4; ++d) { dv[d] = p[d * 32] - lam * o[d][r]; ss += dv[d] * dv[d]; }
                            ss += __shfl_xor(ss, 1); ss += __shfl_xor(ss, 2); ss += __shfl_xor(ss, 4); ss += __shfl_xor(ss, 8); ss += __shfl_xor(ss, 16);
                            const float rstd = 1.f / sqrtf(ss * (1.f / 128.f) + EPS); bf16_t* q = OBb + ((r & 3) + 8 * (r >> 2)) * DM + lo2;
#pragma unroll
                            for (int d = 0; d < 4; ++d) q[d * 32] = (bf16_t)(cvt_pk_bf16(dv[d] * rstd * sg[d], 0.f) & 0xffffu);
                            asm volatile("" ::: "memory"); }
                    }
                }
            }
            if (SUB(3)) REPSUB(8, 3) for (int u = bx; u < 512 + 16; u += G) {
                int b, h, q0, NT, i0;
                if (u < 512) { b = u >> 8; h = (u >> 5) & 7; i0 = (u & 31) * 256; q0 = CTXL + i0; NT = 12; } else { const int v = u - 512; b = v >> 3; h = v & 7; i0 = 0; q0 = 0; NT = 4; }
                const size_t rb = (size_t)b * TB; const float sink = inp(lds, 14)[l * 8 + h];
                f32x16 o[4];
                att::attn_unit<128, true, 1024, 256, NIN>((const bf16_t*)(ws + WS_QS) + (rb + q0) * 1024 + h * 128, (const bf16_t*)(ws + WS_KS) + rb * 256 + (h >> 2) * 128,
                                          (const bf16_t*)(ws + WS_PIECES) + rb * NIN + C_SV + (h >> 2) * 128, NT, 4, i0 - 128, i0, sink * 11.313708498984761f, 1.f, (LAS char*)lds, o);
                int ln = lane; asm volatile("" : "+v"(ln));
                const int r32 = ln & 31, hi5 = ln >> 5;
                bf16_t* OBb = (bf16_t*)(ws + WS_OB) + (rb + q0 + wid * 32) * DM + 2048 + h * 128;
                const unsigned lo2 = (unsigned)(4 * hi5 * DM + r32);
#pragma unroll
                for (int r = 0; r < 16; ++r) { bf16_t* q = OBb + ((r & 3) + 8 * (r >> 2)) * DM + lo2;
#pragma unroll
                    for (int d = 0; d < 4; ++d) q[d * 32] = (bf16_t)(cvt_pk_bf16(o[d][r], 0.f) & 0xffffu);
                    asm volatile("" ::: "memory"); }
            }
        } SEAM(mb + 3);
        if (SITE(9) && IN(mb + 4)) REPS(9) {
            pg8::Gemm g{OB_, (const bf16_t*)(WL_ + WL_WB), DM, DM, DM, 0, 0}; pg8::Order S; S.init(T / 256, DM / 256, 1, G, bx, 1);
            pg8::EpiMergeH E{SIG_, MG_};
            pg8::gemm_phase<pg8::EpiMergeH, true, true>(lds, g, S, E);
        } SEAM(mb + 4);
        if (SITE(10) && IN(mb + 5)) {
            pg8::Gemm g{MG_, (const bf16_t*)(WL_ + WL_WO), DM, DM, DM, 0, 0}; pg8::Order S; S.init(T / 256, DM / 256, 1, G, bx, 1);
            pg8::EpiResid<false> E{XS_, MODL_ + (size_t)5 * DM, args.out, 0};
            pg8::gemm_phase<pg8::EpiResid<false>, true, true>(lds, g, S, E);
        } SEAM(mb + 5);
    }
#undef IN
#undef SEAM
}

#ifndef DBG_NRUN
#define DBG_NRUN 0
#endif
struct DbgSeg { size_t off, n; int bf16; };
#ifndef DBG_SEGS
#define DBG_SEGS {WS_SIG, (size_t)T * 16384, 1}
#endif
__global__ void dbg_dump(const unsigned char* ws, float* out, size_t nout) {
    const DbgSeg segs[] = {DBG_SEGS}; constexpr int NS = sizeof(segs) / sizeof(segs[0]);
    for (size_t i = (size_t)blockIdx.x * blockDim.x + threadIdx.x; i < nout; i += (size_t)gridDim.x * blockDim.x) {
        size_t j = i; int k = 0;
#pragma unroll
        for (int q = 0; q < NS - 1; ++q) if (k == q && j >= segs[q].n) { j -= segs[q].n; k = q + 1; }
        j = j % segs[k].n;
        float v = 0.f;
#pragma unroll
        for (int q = 0; q < NS; ++q) if (k == q) v = segs[q].bf16 ? __uint_as_float((unsigned)((const bf16_t*)(ws + segs[q].off))[j] << 16) : ((const float*)(ws + segs[q].off))[j];
        out[i] = v;
    }
}
extern "C" void kernel_launch(void* const* d_in, const int* in_sizes, int n_in, void* d_out, int out_size, void* d_ws, size_t ws_size, hipStream_t stream) {
    static int grid = 0;
    if (grid == 0) {
        if (n_in != 22 || out_size != NBATCH * SEQ * DM || ws_size < WS_END) { fprintf(stderr, "kernel_launch: unexpected shapes: n_in %d out %d ws %zu (need %zu)\n", n_in, out_size, ws_size, (size_t)WS_END); grid = -1; return; }
        int dev = 0, cus = 0, per_cu = 0;
        if (hipGetDevice(&dev) != hipSuccess || hipDeviceGetAttribute(&cus, hipDeviceAttributeMultiprocessorCount, dev) != hipSuccess) { grid = -1; return; }
        if (hipFuncSetAttribute((const void*)fwd_kernel, hipFuncAttributeMaxDynamicSharedMemorySize, LDS_BYTES) != hipSuccess) { fprintf(stderr, "kernel_launch: hipFuncSetAttribute failed\n"); grid = -1; return; }
        if (hipOccupancyMaxActiveBlocksPerMultiprocessor(&per_cu, (const void*)fwd_kernel, NTHREADS, LDS_BYTES) != hipSuccess || per_cu < 1) { fprintf(stderr, "kernel_launch: occupancy query says %d\n", per_cu); }
        (void)hipGetLastError();
        grid = cus;
    }
    if (grid < 0) return;
    (void)hipMemsetAsync((char*)d_ws + WS_CTL, 0, CTL_ZERO_BYTES, stream);
    Args a{};
    for (int i = 0; i < 22; ++i) a.in[i] = (const float*)d_in[i];
    a.out = (float*)d_out; a.ws = (unsigned char*)d_ws;
#if DBG_NRUN > 0
    for (int p = 0; p < DBG_NRUN; ++p) { a.ph_lo = p; a.ph_hi = p + 1; hipLaunchKernelGGL(fwd_kernel, dim3(grid), dim3(NTHREADS), LDS_BYTES, stream, a); }
    hipLaunchKernelGGL(dbg_dump, dim3(2048), dim3(256), 0, stream, (const unsigned char*)d_ws, (float*)d_out, (size_t)out_size);
#elif MK_PER_PHASE
    for (int p = 0; p < N_PHASES; ++p) { a.ph_lo = p; a.ph_hi = p + 1; hipLaunchKernelGGL(fwd_kernel, dim3(grid), dim3(NTHREADS), LDS_BYTES, stream, a); }
#else
    a.ph_lo = 0; a.ph_hi = N_PHASES;
    hipLaunchKernelGGL(fwd_kernel, dim3(grid), dim3(NTHREADS), LDS_BYTES, stream, a);
#endif
    const hipError_t le = hipPeekAtLastError();
    if (le != hipSuccess) fprintf(stderr, "kernel_launch: launch failed: %s\n", hipGetErrorName(le));
}
```

```cpp
#include <hip/hip_runtime.h>
#include <cstdio>
#include <cstdint>

#ifndef MK_PER_PHASE
#define MK_PER_PHASE 0
#endif

#define LAS __attribute__((address_space(3)))
#define GAS __attribute__((address_space(1)))
typedef unsigned short bf16_t;
typedef short bf16x8 __attribute__((ext_vector_type(8)));
typedef short s16x4 __attribute__((ext_vector_type(4)));
typedef float f32x2 __attribute__((ext_vector_type(2)));
typedef float f32x4 __attribute__((ext_vector_type(4)));
typedef float f32x16 __attribute__((ext_vector_type(16)));
typedef unsigned u32x2 __attribute__((ext_vector_type(2)));
typedef unsigned u32x4 __attribute__((ext_vector_type(4)));

constexpr int DM = 4096, NBATCH = 2, SEQ = 8192, DEPTH = 4, CTXL = 256, TB = CTXL + SEQ, T = NBATCH * TB, DFF = 5120, NIN = 8960, NMOD = 9;
constexpr int PANB = TB / 256;
constexpr int C_FOUR = 0, C_CONVB = 1024, C_CONVC = 2048, C_CONVV = 3072, C_SQ = 4096, C_SK = 5120, C_SV = 5376, C_DQ = 5632, C_DK = 6656, C_DV = 7680, C_Z = 8704;
constexpr float EPS = 1e-6f;
constexpr int NWAVES = 8, NTHREADS = 512;

constexpr size_t MiB = 1u << 20;
constexpr size_t WS_CTL = 0, CTL_ZERO_BYTES = 64 * 1024;
constexpr size_t WS_ROPE = 1 * MiB;
constexpr size_t WS_LAM = 1 * MiB + 512 * 1024;
constexpr size_t WS_T1P = 2 * MiB;
constexpr size_t WS_MOD = 3 * MiB;
constexpr size_t WS_CSCT = 5 * MiB;
constexpr size_t WS_CSCTX = 5 * MiB + 512 * 1024;
constexpr size_t WS_F1 = 6 * MiB;
constexpr size_t WS_F2 = 7 * MiB;
constexpr size_t WS_Y2 = 8 * MiB;
constexpr size_t WS_W = 262 * MiB;
constexpr size_t WL_W13 = 0, WL_W2 = 160 * MiB, WL_WIN = 240 * MiB, WL_WB = 310 * MiB, WL_GATE = 342 * MiB, WL_WO = 350 * MiB, WL_SIZE = 382 * MiB;
constexpr size_t WS_XS = WS_W + DEPTH * WL_SIZE;
constexpr size_t WS_H = WS_XS + 264 * MiB;
constexpr size_t WS_ACT = WS_H + 132 * MiB;
constexpr size_t WS_PIECES = WS_ACT + 165 * MiB;
constexpr size_t WS_QS = WS_PIECES + 289 * MiB;
constexpr size_t WS_KS = WS_QS + 33 * MiB;
constexpr size_t WS_QD = WS_KS + 9 * MiB;
constexpr size_t WS_KD = WS_QD + 33 * MiB;
constexpr size_t WS_ABT = WS_KD + 33 * MiB;
constexpr size_t WS_ABTC = WS_ABT + 64 * MiB;
constexpr size_t WS_OB = WS_ABTC + 2 * MiB;
constexpr size_t WS_SIG = WS_OB + 132 * MiB;
constexpr size_t WS_PART = WS_SIG + 528 * MiB;
constexpr size_t WS_MG = WS_PART + 264 * MiB;
constexpr size_t WS_O1 = WS_MG + 132 * MiB;
constexpr size_t WS_END = WS_O1 + 66 * MiB;
constexpr int CW_BAR = 4096;

constexpr int LDS_BYTES = 147456;
constexpr int MISC_OFF = 144 * 1024 - 256;
constexpr int PTR_OFF = MISC_OFF - 256;

#define RLX_AGENT __ATOMIC_RELAXED, __HIP_MEMORY_SCOPE_AGENT
#define LDS_WAIT() asm volatile("s_waitcnt lgkmcnt(0)" ::: "memory")
#define VM_WAIT() asm volatile("s_waitcnt vmcnt(0)" ::: "memory")
typedef __bf16 bf16x2_t __attribute__((ext_vector_type(2)));
__device__ __forceinline__ unsigned cvt_pk_bf16(float lo, float hi) { const f32x2 v = {lo, hi}; const bf16x2_t b = __builtin_convertvector(v, bf16x2_t); return __builtin_bit_cast(unsigned, b); }
__device__ __forceinline__ float bf_lo(unsigned w) { return __uint_as_float(w << 16); }
__device__ __forceinline__ float bf_hi(unsigned w) { return __uint_as_float(w & 0xffff0000u); }
__device__ __forceinline__ float fast_rcp(float x) { return __builtin_amdgcn_rcpf(x); }
__device__ __forceinline__ float sigmoidf_(float x) { return fast_rcp(1.f + __builtin_amdgcn_exp2f(-1.4426950408889634f * x)); }

namespace pg8 {
constexpr int BM = 256, BK = 64, HALF = 128, HTB = HALF * BK * 2, STAGE_BYTES = 8 * HTB, NXCD = 8, WGM = 8;
__host__ __device__ __forceinline__ int lds_byte(int r, int c) { const int st = (r >> 4) * 2 + (c >> 5), rr = r & 15, cc = c & 31, ob = rr * 64 + cc * 2; return st * 1024 + (ob ^ (((ob >> 9) & 1) << 5)); }
__host__ __device__ __forceinline__ void stage_rc(int b, int& R, int& C) { const int st = b / 1024, sb = b % 1024, swz = sb ^ (((sb >> 9) & 1) << 5); R = (st >> 1) * 16 + swz / 64; C = (st & 1) * 32 + (swz % 64) / 2; }
__host__ __device__ __forceinline__ int perm32(int rho) { const int n = rho >> 4, i = rho & 15; return 8 * (i >> 2) + 4 * n + (i & 3); }

struct Unit { int pm, pn, pz, kt; };
struct Gemm { const bf16_t* A; const bf16_t* Bt; int K, lda, ldb; long bsA, bsB; int zsplit; long bsA2, bsB2; long tsB; int gatherB; };
__device__ __forceinline__ Gemm mk_gemm(const bf16_t* A, const bf16_t* Bt, int K, int lda, int ldb, long bsA, long bsB) { Gemm g; g.A = A; g.Bt = Bt; g.K = K; g.lda = lda; g.ldb = ldb; g.bsA = bsA; g.bsB = bsB; g.zsplit = 0; g.bsA2 = 0; g.bsB2 = 0; g.tsB = 0; g.gatherB = 0; return g; }

struct Order {
    int nM, nN, nZ, nwg, G, c, mode, S, skip, KT;
    __device__ __forceinline__ void init(int nM_, int nN_, int nZ_, int G_, int c_, int KT_) { nM = nM_; nN = nN_; nZ = nZ_; nwg = nM * nN; G = G_; c = c_; mode = 0; S = 1; skip = 0; KT = KT_; }
    __device__ __forceinline__ void init_tok(int nN_, int G_, int c_, int KT_, int S_, int skip_) { nM = 64; nN = nN_; nZ = 1; nwg = 64 * nN_; G = G_; c = c_; mode = 1; S = S_; skip = skip_; KT = KT_; }
    __device__ __forceinline__ bool next(int i, Unit& u) const {
        long L = (long)i * G + c; int pz = 0;
        if (mode == 0) { if (L >= (long)nwg * nZ) return false; pz = (int)(L / nwg); L = L % nwg; }
        else if (L >= nwg) {
            if (skip) return false;
            const int idx = (int)(L - nwg); if (idx >= 2 * nN * S) return false;
            const int tile = idx / S; u.pz = idx % S; u.pm = (tile / nN) * PANB; u.pn = tile % nN; u.kt = KT / S; return true;
        }
        int wgid = (int)L; { const int q = nwg / NXCD, r = nwg % NXCD, xcd = wgid % NXCD, off = wgid / NXCD; wgid = (xcd < r ? xcd * (q + 1) : r * (q + 1) + (xcd - r) * q) + off; }
        const int nig = WGM * nN, gid = wgid / nig, fm = gid * WGM, gsz = (nM - fm) < WGM ? (nM - fm) : WGM;
        int pm = fm + ((wgid % nig) % gsz); if (mode == 1) pm = (pm >> 5) * PANB + 1 + (pm & 31);
        u.pm = pm; u.pn = (wgid % nig) / gsz; u.pz = pz; u.kt = KT; return true;
    }
};

typedef f32x4 Acc[2][2][4][2];

template <class Epi, bool ALIGN_EPI, bool SP2>
__device__ __forceinline__ void gemm_phase(LAS unsigned char* lds, const Gemm g, const Order S, const Epi E) {
    int tid_ = threadIdx.x; asm volatile("" : "+v"(tid_));
    const int tid = tid_, wid = __builtin_amdgcn_readfirstlane(tid >> 6), lane = tid & 63, wr = wid >> 2, wc = wid & 3, fr = lane & 15, fq = lane >> 4;
    unsigned voffA[2], voffB[2];
#pragma unroll
    for (int i = 0; i < 2; ++i) { int R, C; stage_rc(tid * 16 + i * 8192, R, C); const int Rb = Epi::PERM ? ((R & ~31) + perm32(R & 31)) : R;
        const int Rg = g.gatherB ? 128 * (Rb & 63) + (Rb >> 6) : Rb;
        voffA[i] = (unsigned)(R * g.lda + C) * 2u; voffB[i] = (unsigned)(Rg * g.ldb + C) * 2u; }
    const size_t kstep = (size_t)(BK * 2);
    const size_t hstepA = (size_t)HALF * g.lda * 2, hstepB = g.gatherB ? (size_t)2 * g.ldb * 2 : (size_t)HALF * g.ldb * 2;
    const size_t tstepA = 2 * hstepA, tstepB = g.tsB ? (size_t)g.tsB : 2 * hstepB;
    const unsigned ldsw = (unsigned)wid * 1024u;
    const int aoff = lds_byte(wr * 64 + fr, fq * 8), boff = lds_byte(wc * 32 + fr, fq * 8);
#define PG8_SA(b, h) (((b) * 2 + (h)) * HTB)
#define PG8_SB(b, h) ((4 + (b) * 2 + (h)) * HTB)
#define PG8_STAGE(bufoff, gbase, voff) do { _Pragma("unroll") for (int _i = 0; _i < 2; ++_i) \
        __builtin_amdgcn_global_load_lds((const unsigned*)((const char*)(gbase) + (voff)[_i]), (LAS unsigned*)(lds + (bufoff) + ldsw + _i * 8192), 16, 0, 0); } while (0)
#define PG8_LDA(dst, b, h) do { _Pragma("unroll") for (int m = 0; m < 4; ++m) _Pragma("unroll") for (int k = 0; k < 2; ++k) dst[m][k] = *(const LAS bf16x8*)(lds + PG8_SA(b, h) + aoff + m * 2048 + k * 1024); } while (0)
#define PG8_LDB(dst, b, h) do { _Pragma("unroll") for (int n = 0; n < 2; ++n) _Pragma("unroll") for (int k = 0; k < 2; ++k) dst[n][k] = *(const LAS bf16x8*)(lds + PG8_SB(b, h) + boff + n * 2048 + k * 1024); } while (0)
#define PG8_MMA(ai, bj, At, Bt) do { __builtin_amdgcn_s_setprio(1); _Pragma("unroll") for (int m = 0; m < 4; ++m) _Pragma("unroll") for (int n = 0; n < 2; ++n) _Pragma("unroll") for (int k = 0; k < 2; ++k) \
        acc[ai][bj][m][n] = __builtin_amdgcn_mfma_f32_16x16x32_bf16(Bt[n][k], At[m][k], acc[ai][bj][m][n], 0, 0, 0); __builtin_amdgcn_s_setprio(0); } while (0)
#define PG8_WAIT_V(n) asm volatile("s_waitcnt vmcnt(" #n ")" ::: "memory")
#define PG8_WAIT_L(n) asm volatile("s_waitcnt lgkmcnt(" #n ")" ::: "memory")
#define PG8_BAR __builtin_amdgcn_s_barrier()
#define PG8_SCHED __builtin_amdgcn_sched_barrier(0)
    Unit cur, nxt; int ui = 0;
    if (!S.next(0, cur)) return;
    Acc acc;
#pragma unroll
    for (int a = 0; a < 2; ++a)
#pragma unroll
        for (int b = 0; b < 2; ++b)
#pragma unroll
            for (int m = 0; m < 4; ++m)
#pragma unroll
                for (int n = 0; n < 2; ++n) acc[a][b][m][n] = (f32x4){0.f, 0.f, 0.f, 0.f};
    bf16x8 At[4][2], B0[2][2], B1[2][2];
#define PG8_ZA(u) (g.zsplit ? (size_t)((u).pz % g.zsplit) * g.bsA * 2 + (size_t)((u).pz / g.zsplit) * g.bsA2 * 2 : (size_t)(u).pz * g.bsA * 2)
#define PG8_ZB(u) (g.zsplit ? (size_t)((u).pz % g.zsplit) * g.bsB * 2 + (size_t)((u).pz / g.zsplit) * g.bsB2 * 2 : (size_t)(u).pz * g.bsB * 2)
    const char* cA = (const char*)g.A + (size_t)cur.pm * tstepA + PG8_ZA(cur); const char* cB = (const char*)g.Bt + (size_t)cur.pn * tstepB + PG8_ZB(cur);
    if constexpr (SP2) {
        PG8_STAGE(PG8_SB(0, 0), cB, voffB); PG8_STAGE(PG8_SB(0, 1), cB + hstepB, voffB); PG8_STAGE(PG8_SA(0, 0), cA, voffA); PG8_STAGE(PG8_SA(0, 1), cA + hstepA, voffA);
        if (wr == 1) PG8_BAR;
        PG8_WAIT_V(2); PG8_BAR;
        PG8_STAGE(PG8_SB(1, 0), cB + kstep, voffB); PG8_STAGE(PG8_SA(1, 0), cA + kstep, voffA); PG8_STAGE(PG8_SB(1, 1), cB + hstepB + kstep, voffB);
        PG8_WAIT_V(6); PG8_BAR;
    } else {
        PG8_STAGE(PG8_SB(0, 0), cB, voffB); PG8_STAGE(PG8_SA(0, 0), cA, voffA); PG8_STAGE(PG8_SB(0, 1), cB + hstepB, voffB); PG8_STAGE(PG8_SA(0, 1), cA + hstepA, voffA);
        if (wr == 1) PG8_BAR;
        PG8_WAIT_V(4); PG8_BAR;
        PG8_STAGE(PG8_SB(1, 0), cB + kstep, voffB); PG8_STAGE(PG8_SA(1, 0), cA + kstep, voffA); PG8_STAGE(PG8_SB(1, 1), cB + hstepB + kstep, voffB);
        PG8_WAIT_V(6); PG8_BAR;
    }
    for (;;) {
        const bool has_next = S.next(ui + 1, nxt);
        const char* nA = has_next ? (const char*)g.A + (size_t)nxt.pm * tstepA + PG8_ZA(nxt) : cA;
        const char* nB = has_next ? (const char*)g.Bt + (size_t)nxt.pn * tstepB + PG8_ZB(nxt) : cB;
        const int nt = cur.kt;
#pragma nounroll
        for (int t = 0; t < nt; t += 2) {
            const bool last = (t == nt - 2);
            const char* a1 = cA + (size_t)(t + 1) * kstep;
            const char* a2 = last ? nA : cA + (size_t)(t + 2) * kstep; const char* b2 = last ? nB : cB + (size_t)(t + 2) * kstep;
            const char* a3 = a2 + kstep; const char* b3 = b2 + kstep;
            if constexpr (Epi::HOOK) E.hook(acc, cur, t, wr, wc, fr, fq);
            if constexpr (SP2) {
            PG8_LDB(B0, 0, 0); PG8_LDB(B1, 0, 1); PG8_SCHED; PG8_LDA(At, 0, 0); PG8_STAGE(PG8_SA(1, 1), a1 + hstepA, voffA);
            PG8_WAIT_V(8); PG8_WAIT_L(0); PG8_BAR; PG8_MMA(0, 0, At, B0); PG8_MMA(0, 1, At, B1); PG8_BAR; PG8_SCHED;
            PG8_LDA(At, 0, 1); PG8_STAGE(PG8_SB(0, 0), b2, voffB); PG8_STAGE(PG8_SB(0, 1), b2 + hstepB, voffB); PG8_STAGE(PG8_SA(0, 0), a2, voffA);
            PG8_WAIT_V(8); PG8_WAIT_L(0); PG8_BAR; PG8_MMA(1, 0, At, B0); PG8_MMA(1, 1, At, B1); PG8_BAR; PG8_SCHED;
            PG8_LDB(B0, 1, 0); PG8_LDB(B1, 1, 1); PG8_SCHED; PG8_LDA(At, 1, 0); PG8_STAGE(PG8_SA(0, 1), a2 + hstepA, voffA);
            PG8_WAIT_V(8); PG8_WAIT_L(0); PG8_BAR; PG8_MMA(0, 0, At, B0); PG8_MMA(0, 1, At, B1); PG8_BAR; PG8_SCHED;
            PG8_LDA(At, 1, 1); PG8_STAGE(PG8_SB(1, 0), b3, voffB); PG8_STAGE(PG8_SB(1, 1), b3 + hstepB, voffB); PG8_STAGE(PG8_SA(1, 0), a3, voffA);
            PG8_WAIT_V(8); PG8_WAIT_L(0); PG8_BAR; PG8_MMA(1, 0, At, B0); PG8_MMA(1, 1, At, B1); PG8_BAR; PG8_SCHED;
            } else {
            PG8_LDB(B0, 0, 0); PG8_SCHED; PG8_LDA(At, 0, 0); PG8_STAGE(PG8_SA(1, 1), a1 + hstepA, voffA);
            PG8_WAIT_L(8); PG8_BAR; PG8_WAIT_L(0); PG8_MMA(0, 0, At, B0); PG8_BAR; PG8_SCHED;
            PG8_LDB(B1, 0, 1); PG8_STAGE(PG8_SB(0, 0), b2, voffB);
            PG8_BAR; PG8_WAIT_L(0); PG8_MMA(0, 1, At, B1); PG8_BAR;
            PG8_LDA(At, 0, 1); PG8_STAGE(PG8_SA(0, 0), a2, voffA);
            PG8_BAR; PG8_WAIT_L(0); PG8_MMA(1, 0, At, B0); PG8_BAR; PG8_SCHED;
            PG8_STAGE(PG8_SB(0, 1), b2 + hstepB, voffB);
            PG8_WAIT_V(6); PG8_BAR; PG8_MMA(1, 1, At, B1); PG8_BAR;
            PG8_LDB(B0, 1, 0); PG8_SCHED; PG8_LDA(At, 1, 0); PG8_STAGE(PG8_SA(0, 1), a2 + hstepA, voffA);
            PG8_WAIT_L(8); PG8_BAR; PG8_WAIT_L(0); PG8_MMA(0, 0, At, B0); PG8_BAR; PG8_SCHED;
            PG8_LDB(B1, 1, 1); PG8_STAGE(PG8_SB(1, 0), b3, voffB);
            PG8_BAR; PG8_WAIT_L(0); PG8_MMA(0, 1, At, B1); PG8_BAR;
            PG8_LDA(At, 1, 1); PG8_STAGE(PG8_SA(1, 0), a3, voffA);
            PG8_BAR; PG8_WAIT_L(0); PG8_MMA(1, 0, At, B0); PG8_BAR; PG8_SCHED;
            PG8_STAGE(PG8_SB(1, 1), b3 + hstepB, voffB);
            PG8_WAIT_V(6); PG8_BAR; PG8_MMA(1, 1, At, B1); PG8_BAR;
            }
        }
        if constexpr (ALIGN_EPI) { if (wr == 0) PG8_BAR; }
        E(acc, cur, wr, wc, fr, fq);
        if (!has_next) break;
#pragma unroll
        for (int a = 0; a < 2; ++a)
#pragma unroll
            for (int b = 0; b < 2; ++b)
#pragma unroll
                for (int m = 0; m < 4; ++m)
#pragma unroll
                    for (int n = 0; n < 2; ++n) acc[a][b][m][n] = (f32x4){0.f, 0.f, 0.f, 0.f};
        cur = nxt; cA = nA; cB = nB; ++ui;
        if constexpr (ALIGN_EPI) { if (wr == 1) PG8_BAR; }
    }
    PG8_WAIT_V(0);
    if constexpr (!ALIGN_EPI) { if (wr == 0) PG8_BAR; }
    PG8_BAR;
#undef PG8_ZA
#undef PG8_ZB
#undef PG8_SA
#undef PG8_SB
#undef PG8_STAGE
#undef PG8_LDA
#undef PG8_LDB
#undef PG8_MMA
#undef PG8_WAIT_V
#undef PG8_WAIT_L
#undef PG8_BAR
#undef PG8_SCHED
}

struct EpiBf16 {
    static constexpr bool PERM = true, HOOK = false;
    bf16_t* O; int ldc; long rbase, zstride; float scale;
    __device__ __forceinline__ void operator()(const Acc& acc, const Unit& u, int wr, int wc, int fr, int fq) const {
        const long row0 = rbase + (long)u.pz * zstride + u.pm * BM + wr * 64 + fr; const int col0 = u.pn * BM + wc * 32 + 8 * fq;
#pragma unroll
        for (int ai = 0; ai < 2; ++ai)
#pragma unroll
            for (int m = 0; m < 4; ++m) { bf16_t* rowp = O + (size_t)(row0 + ai * HALF + m * 16) * ldc + col0;
#pragma unroll
                for (int bj = 0; bj < 2; ++bj) { const f32x4 v0 = acc[ai][bj][m][0] * scale, v1 = acc[ai][bj][m][1] * scale;
                    u32x4 w; w.x = cvt_pk_bf16(v0[0], v0[1]); w.y = cvt_pk_bf16(v0[2], v0[3]); w.z = cvt_pk_bf16(v1[0], v1[1]); w.w = cvt_pk_bf16(v1[2], v1[3]);
                    *(u32x4*)(rowp + bj * HALF) = w; }
                asm volatile("" ::: "memory"); }
    }
};
struct EpiSwiGLU {
    static constexpr bool PERM = true, HOOK = false;
    bf16_t* O; int ldc;
    __device__ __forceinline__ void operator()(const Acc& acc, const Unit& u, int wr, int wc, int fr, int fq) const {
        const int row0 = u.pm * BM + wr * 64 + fr, col0 = u.pn * HALF + wc * 32 + 8 * fq;
#pragma unroll
        for (int ai = 0; ai < 2; ++ai)
#pragma unroll
            for (int m = 0; m < 4; ++m) { bf16_t* rowp = O + (size_t)(row0 + ai * HALF + m * 16) * ldc + col0;
                float v[8];
#pragma unroll
                for (int n = 0; n < 2; ++n)
#pragma unroll
                    for (int j = 0; j < 4; ++j) { const float a = acc[ai][0][m][n][j], g = acc[ai][1][m][n][j]; v[n * 4 + j] = a * sigmoidf_(a) * g; }
                u32x4 w; w.x = cvt_pk_bf16(v[0], v[1]); w.y = cvt_pk_bf16(v[2], v[3]); w.z = cvt_pk_bf16(v[4], v[5]); w.w = cvt_pk_bf16(v[6], v[7]);
                *(u32x4*)rowp = w; asm volatile("" ::: "memory"); }
    }
};
template <bool HALFSTEP>
struct EpiResid {
    static constexpr bool PERM = false, HOOK = false;
    float* X; const float* coef; float* dout; int fin; float* PK;
    __device__ __forceinline__ void operator()(const Acc& acc, const Unit& u, int wr, int wc, int fr, int fq) const {
        constexpr float f = HALFSTEP ? 0.5f : 1.f;
        const int b = u.pm / PANB, ip = u.pm % PANB, v = (ip == 0) ? 2 : b;
        if (ip == 0) {
            float* pk = PK + ((size_t)(u.pz * 2 + b) * 256 + wr * 64 + fr) * DM + u.pn * BM + wc * 32 + 4 * fq;
#pragma unroll
            for (int ai = 0; ai < 2; ++ai)
#pragma unroll
                for (int m = 0; m < 4; ++m) {
#pragma unroll
                    for (int bj = 0; bj < 2; ++bj)
#pragma unroll
                        for (int n = 0; n < 2; ++n) *(f32x4*)(pk + (size_t)(ai * HALF + m * 16) * DM + bj * HALF + n * 16) = acc[ai][bj][m][n];
                    asm volatile("" ::: "memory"); }
        } else {
        const int row0 = u.pm * BM + wr * 64 + fr, col0 = u.pn * BM + wc * 32 + 4 * fq;
        const float* cf = coef + (size_t)v * (NMOD * DM) + col0;
        f32x4 cv[2][2];
#pragma unroll
        for (int bj = 0; bj < 2; ++bj)
#pragma unroll
            for (int n = 0; n < 2; ++n) cv[bj][n] = *(const f32x4*)(cf + bj * HALF + n * 16) * f;
        const float* sbase = X + (size_t)row0 * DM + col0;
        float* dbase = fin ? dout + (size_t)(row0 - CTXL * (b + 1)) * DM + col0 : X + (size_t)row0 * DM + col0;
#pragma unroll
        for (int ai = 0; ai < 2; ++ai) { f32x4 x[4][2][2];
#pragma unroll
            for (int m = 0; m < 4; ++m)
#pragma unroll
                for (int bj = 0; bj < 2; ++bj)
#pragma unroll
                    for (int n = 0; n < 2; ++n) x[m][bj][n] = *(const f32x4*)(sbase + (size_t)(ai * HALF + m * 16) * DM + bj * HALF + n * 16);
#pragma unroll
            for (int m = 0; m < 4; ++m)
#pragma unroll
                for (int bj = 0; bj < 2; ++bj)
#pragma unroll
                    for (int n = 0; n < 2; ++n) *(f32x4*)(dbase + (size_t)(ai * HALF + m * 16) * DM + bj * HALF + n * 16) = x[m][bj][n] + cv[bj][n] * acc[ai][bj][m][n];
            asm volatile("" ::: "memory"); }
        }
    }
};
struct EpiChan2 {
    static constexpr bool PERM = true, HOOK = false;
    bf16_t* ABT;
    __device__ __forceinline__ void operator()(const Acc& acc, const Unit& u, int wr, int wc, int fr, int fq) const {
        const int g = u.pz & 3, b = u.pz >> 2, cs = u.pm, t1 = 32 * (wc & 1) + 8 * fq;
        bf16_t* base = ABT + ((size_t)(b * 1024 + g * 256 + wr * 64 + fr)) * 16384 + cs * 64 + t1;
#pragma unroll
        for (int ai = 0; ai < 2; ++ai)
#pragma unroll
            for (int m = 0; m < 4; ++m) {
#pragma unroll
                for (int bj = 0; bj < 2; ++bj) { const int t2 = 4 * u.pn + 2 * bj + (wc >> 1); const f32x4 v0 = acc[ai][bj][m][0], v1 = acc[ai][bj][m][1];
                    u32x4 w; w.x = cvt_pk_bf16(v0[0], v0[1]); w.y = cvt_pk_bf16(v0[2], v0[3]); w.z = cvt_pk_bf16(v1[0], v1[1]); w.w = cvt_pk_bf16(v1[2], v1[3]);
                    *(u32x4*)(base + (size_t)(ai * HALF + m * 16) * 16384 + ((t2 & 63) * 2 + (t2 >> 6)) * 128) = w; }
                asm volatile("" ::: "memory"); }
    }
};
struct EpiChanC {
    static constexpr bool PERM = true, HOOK = false;
    bf16_t* ABTC;
    __device__ __forceinline__ void operator()(const Acc& acc, const Unit& u, int wr, int wc, int fr, int fq) const {
        bf16_t* base = ABTC + ((size_t)(u.pn * 1024 + u.pz * 256 + wr * 64 + fr)) * 512 + u.pm * 256 + wc * 32 + 8 * fq;
#pragma unroll
        for (int ai = 0; ai < 2; ++ai)
#pragma unroll
            for (int m = 0; m < 4; ++m) { bf16_t* rowp = base + (size_t)(ai * HALF + m * 16) * 512;
#pragma unroll
                for (int bj = 0; bj < 2; ++bj) { const f32x4 v0 = acc[ai][bj][m][0], v1 = acc[ai][bj][m][1];
                    u32x4 w; w.x = cvt_pk_bf16(v0[0], v0[1]); w.y = cvt_pk_bf16(v0[2], v0[3]); w.z = cvt_pk_bf16(v1[0], v1[1]); w.w = cvt_pk_bf16(v1[2], v1[3]);
                    *(u32x4*)(rowp + bj * HALF) = w; }
                asm volatile("" ::: "memory"); }
    }
};
struct EpiFft1 {
    static constexpr bool PERM = true, HOOK = false;
    bf16_t* Y2;
    __device__ __forceinline__ void operator()(const Acc& acc, const Unit& u, int wr, int wc, int fr, int fq) const {
        int t2b = wr * 64 + 32 * (wc & 1) + 8 * fq; asm volatile("" : "+v"(t2b));
#pragma unroll
        for (int m = 0; m < 4; ++m) { const int k1 = 16 * m + fr;
#pragma unroll
            for (int h = 0; h < 2; ++h) { float c[4], sn[4];
#pragma unroll
                for (int j = 0; j < 4; ++j) { const float x = (float)(k1 * (t2b + 4 * h + j)) * (1.f / 8192.f); c[j] = __builtin_amdgcn_cosf(x); sn[j] = __builtin_amdgcn_sinf(x); }
#pragma unroll
                for (int bj = 0; bj < 2; ++bj) { const int nb = 4 * u.pn + 2 * bj + (wc >> 1), n = nb & 1023, b = nb >> 10;
                    const unsigned off = (unsigned)((((b * 32 + (k1 >> 1)) * 1024 + n) * 4 + (k1 & 1) * 2) * 128 + t2b + 4 * h) * 2u;
                    const f32x4 xr = acc[0][bj][m][h], xi = acc[1][bj][m][h]; float re[4], im[4];
#pragma unroll
                    for (int j = 0; j < 4; ++j) { re[j] = xr[j] * c[j] + xi[j] * sn[j]; im[j] = xi[j] * c[j] - xr[j] * sn[j]; }
                    u32x2 w; w.x = cvt_pk_bf16(re[0], re[1]); w.y = cvt_pk_bf16(re[2], re[3]); *(u32x2*)((char*)Y2 + off) = w;
                    w.x = cvt_pk_bf16(im[0], im[1]); w.y = cvt_pk_bf16(im[2], im[3]); *(u32x2*)((char*)Y2 + off + 256) = w; }
                asm volatile("" ::: "memory"); } }
    }
};
struct EpiFft2 {
    static constexpr bool PERM = true, HOOK = false;
    bf16_t* O;
    __device__ __forceinline__ void operator()(const Acc& acc, const Unit& u, int wr, int wc, int fr, int fq) const {
        const int b = u.pn >> 7, k1pair = (u.pn >> 2) & 31, n0 = 256 * (u.pn & 3) + wc * 32 + 8 * fq; constexpr float scale = 6.9053396600248786e-4f;
#pragma unroll
        for (int ai = 0; ai < 2; ++ai)
#pragma unroll
            for (int m = 0; m < 4; ++m) { const int k = 2 * k1pair + ai + 64 * (64 * wr + 16 * m + fr); bf16_t* rowp = O + (size_t)(b * TB + CTXL + k) * DM + n0;
#pragma unroll
                for (int bj = 0; bj < 2; ++bj) { const f32x4 v0 = acc[ai][bj][m][0] * scale, v1 = acc[ai][bj][m][1] * scale;
                    u32x4 w; w.x = cvt_pk_bf16(v0[0], v0[1]); w.y = cvt_pk_bf16(v0[2], v0[3]); w.z = cvt_pk_bf16(v1[0], v1[1]); w.w = cvt_pk_bf16(v1[2], v1[3]);
                    *(u32x4*)(rowp + bj * HALF) = w; }
                asm volatile("" ::: "memory"); }
    }
};
struct EpiGate {
    static constexpr bool PERM = false, HOOK = false;
    bf16_t* RAT;
    __device__ __forceinline__ void operator()(const Acc& acc, const Unit& u, int wr, int wc, int fr, int fq) const {
        const int row0 = u.pm * BM + wr * 64 + fr, c0 = u.pn * 64 + wc * 16 + 4 * fq;
#pragma unroll
        for (int ai = 0; ai < 2; ++ai)
#pragma unroll
            for (int m = 0; m < 4; ++m) { bf16_t* rowp = RAT + (size_t)(row0 + ai * HALF + m * 16) * 16384 + c0;
                f32x4 d[4], iv[4];
#pragma unroll
                for (int i = 0; i < 4; ++i)
#pragma unroll
                    for (int j = 0; j < 4; ++j) { const float g = fminf(fmaxf(acc[ai][i >> 1][m][i & 1][j], -30.f), 30.f); d[i][j] = 1.f + __builtin_amdgcn_exp2f(-1.4426950408889634f * g); iv[i][j] = fast_rcp(d[i][j]); }
#pragma unroll
                for (int i = 0; i < 4; ++i) { const f32x4 v = (i < 3) ? d[i + 1] * iv[i] : iv[3];
                    u32x2 w; w.x = cvt_pk_bf16(v[0], v[1]); w.y = cvt_pk_bf16(v[2], v[3]); *(u32x2*)(rowp + i * DM) = w; }
                asm volatile("" ::: "memory"); }
    }
};
struct EpiMergeH {
    static constexpr bool PERM = false, HOOK = true;
    const bf16_t* RAT; bf16_t* MG;
    __device__ __forceinline__ void scale(Acc& acc, const Unit& u, int i, int wr, int wc, int fr, int fq) const {
        const int row0 = u.pm * BM + wr * 64 + fr, col0 = u.pn * BM + wc * 32 + 4 * fq;
        const bf16_t* base = RAT + (size_t)row0 * 16384 + (size_t)i * DM + col0;
#pragma unroll
        for (int ai = 0; ai < 2; ++ai) { u32x2 sg[4][2][2];
#pragma unroll
            for (int m = 0; m < 4; ++m)
#pragma unroll
                for (int bj = 0; bj < 2; ++bj)
#pragma unroll
                    for (int n = 0; n < 2; ++n) sg[m][bj][n] = *(const u32x2*)(base + (size_t)(ai * HALF + m * 16) * 16384 + bj * HALF + n * 16);
#pragma unroll
            for (int m = 0; m < 4; ++m)
#pragma unroll
                for (int bj = 0; bj < 2; ++bj)
#pragma unroll
                    for (int n = 0; n < 2; ++n) { f32x4 s; s[0] = bf_lo(sg[m][bj][n].x); s[1] = bf_hi(sg[m][bj][n].x); s[2] = bf_lo(sg[m][bj][n].y); s[3] = bf_hi(sg[m][bj][n].y); acc[ai][bj][m][n] *= s; }
            asm volatile("" ::: "memory"); }
    }
    __device__ __forceinline__ void hook(Acc& acc, const Unit& u, int t, int wr, int wc, int fr, int fq) const { if (t > 0 && (t & 15) == 0) scale(acc, u, (t >> 4) - 1, wr, wc, fr, fq); }
    __device__ __forceinline__ void operator()(Acc& acc, const Unit& u, int wr, int wc, int fr, int fq) const {
        scale(acc, u, 3, wr, wc, fr, fq);
        const int row0 = u.pm * BM + wr * 64 + fr, col0 = u.pn * BM + wc * 32 + 4 * fq;
#pragma unroll
        for (int ai = 0; ai < 2; ++ai)
#pragma unroll
            for (int m = 0; m < 4; ++m) { bf16_t* rowp = MG + (size_t)(row0 + ai * HALF + m * 16) * DM + col0;
#pragma unroll
                for (int bj = 0; bj < 2; ++bj)
#pragma unroll
                    for (int n = 0; n < 2; ++n) { const f32x4 v = acc[ai][bj][m][n]; u32x2 w; w.x = cvt_pk_bf16(v[0], v[1]); w.y = cvt_pk_bf16(v[2], v[3]); *(u32x2*)(rowp + bj * HALF + n * 16) = w; }
                asm volatile("" ::: "memory"); }
    }
};
}

namespace att {
constexpr float THR = 8.f;
#define SBAR() __builtin_amdgcn_sched_barrier(0)
__device__ __forceinline__ int crow(int r, int hi) { return (r & 3) + 8 * (r >> 2) + 4 * hi; }
template <int DQK> __device__ __forceinline__ int kswz(int row, int colB) {
    if (DQK == 128) return row * 256 + (colB ^ ((row & 7) << 4));
    else return row * 128 + (colB ^ (((row >> 1) & 7) << 4));
}
template <int DQK, bool MASKED>
__device__ __forceinline__ void partialSM(f32x16& p0, f32x16& p1, float& m_reg, float& mn, float& alpha, bool domask, int dk, int kp0, int hi) {
    constexpr float SCALE = DQK == 128 ? 0.08838834764831845f : 0.125f;
    constexpr float C = SCALE * 1.4426950408889634f;
    if (MASKED && domask) {
#pragma unroll
        for (int r = 0; r < 16; ++r) { const int kk = crow(r, hi); const int d0 = dk + kk, k0 = kp0 + kk, d1 = d0 + 32, k1 = k0 + 32;
            const bool ok0 = (d0 >= -128) & (d0 <= 128) & (k0 >= 0) & (k0 < SEQ), ok1 = (d1 >= -128) & (d1 <= 128) & (k1 >= 0) & (k1 < SEQ);
            p0[r] = ok0 ? p0[r] : -1e30f; p1[r] = ok1 ? p1[r] : -1e30f; }
    }
    float pmax = p0[0];
#pragma unroll
    for (int r = 1; r < 16; ++r) pmax = fmaxf(pmax, p0[r]);
#pragma unroll
    for (int r = 0; r < 16; ++r) pmax = fmaxf(pmax, p1[r]);
    { auto rr = __builtin_amdgcn_permlane32_swap(__float_as_uint(pmax), __float_as_uint(pmax), false, false);
      pmax = fmaxf(__uint_as_float(rr[0]), __uint_as_float(rr[1])); }
    if (__builtin_expect(__all(pmax - m_reg <= THR / SCALE), 1)) { mn = m_reg; alpha = 1.f; }
    else { mn = fmaxf(m_reg, pmax); alpha = __builtin_amdgcn_exp2f((m_reg - mn) * C); m_reg = mn; }
    const float mnC = -mn * C;
#pragma unroll
    for (int r = 0; r < 16; ++r) p0[r] = fmaf(p0[r], C, mnC);
#pragma unroll
    for (int r = 0; r < 16; ++r) p1[r] = fmaf(p1[r], C, mnC);
#pragma unroll
    for (int r = 0; r < 16; ++r) p0[r] = __builtin_amdgcn_exp2f(p0[r]);
}
__device__ __forceinline__ void finishSM(f32x16& p0, f32x16& p1, float alpha, float& l_reg, bf16x8& pa0, bf16x8& pa1, bf16x8& pa2, bf16x8& pa3) {
#pragma unroll
    for (int r = 0; r < 16; ++r) p1[r] = __builtin_amdgcn_exp2f(p1[r]);
    float ps = 0;
#pragma unroll
    for (int r = 0; r < 16; ++r) ps += p0[r];
#pragma unroll
    for (int r = 0; r < 16; ++r) ps += p1[r];
    { auto rr = __builtin_amdgcn_permlane32_swap(__float_as_uint(ps), __float_as_uint(ps), false, false);
      ps = __uint_as_float(rr[0]) + __uint_as_float(rr[1]); }
    l_reg = l_reg * alpha + ps;
#define PK4(P, BASE, OUT) do { unsigned a0 = cvt_pk_bf16(P[BASE + 0], P[BASE + 1]), a1 = cvt_pk_bf16(P[BASE + 2], P[BASE + 3]);   \
    unsigned b0 = cvt_pk_bf16(P[BASE + 4], P[BASE + 5]), b1 = cvt_pk_bf16(P[BASE + 6], P[BASE + 7]);                              \
    auto r0 = __builtin_amdgcn_permlane32_swap(a0, b0, false, false); auto r1 = __builtin_amdgcn_permlane32_swap(a1, b1, false, false); \
    u32x4 w = {r0[0], r1[0], r0[1], r1[1]}; OUT = *reinterpret_cast<bf16x8*>(&w); } while (0)
    PK4(p0, 0, pa0); PK4(p0, 8, pa1); PK4(p1, 0, pa2); PK4(p1, 8, pa3);
#undef PK4
}
template <int DQK>
__device__ __forceinline__ void qkt(f32x16& p0, f32x16& p1, const LAS char* Ks, const bf16x8* qr, int r32, int hi) {
    p0 = f32x16{}; p1 = f32x16{};
#pragma unroll
    for (int d0 = 0; d0 < DQK / 16; ++d0) { const int cb = (d0 * 16 + hi * 8) * 2;
        const bf16x8 b0 = *reinterpret_cast<const LAS bf16x8*>(Ks + kswz<DQK>(r32, cb));
        const bf16x8 b1 = *reinterpret_cast<const LAS bf16x8*>(Ks + kswz<DQK>(32 + r32, cb));
        p0 = __builtin_amdgcn_mfma_f32_32x32x16_bf16(b0, qr[d0], p0, 0, 0, 0);
        p1 = __builtin_amdgcn_mfma_f32_32x32x16_bf16(b1, qr[d0], p1, 0, 0, 0); }
}
__device__ __forceinline__ int v_st(int k, int c) { const int kk = (k & ~0xC) | ((k & 4) << 1) | ((k & 8) >> 1); return ((kk >> 3) * 4 + (c >> 5)) * 512 + ((kk & 7) * 32 + (c & 31)) * 2; }
__device__ __forceinline__ int v_rd_base(int lane) { return ((lane & 3) << 3) | (((lane >> 2) & 3) << 6) | (((lane >> 4) & 1) << 5) | (((lane >> 5) & 1) << 8); }
constexpr int v_rd_off(int d0, int ks, int half) { return d0 * 512 + ks * 4096 + half * 2048; }
template <int OFF> __device__ __forceinline__ s16x4 tr_read(int vb) {
    s16x4 r; asm volatile("ds_read_b64_tr_b16 %0, %1 offset:%2" : "=&v"(r) : "v"(vb), "i"(OFF) : "memory"); return r;
}
template <int D0> __device__ __forceinline__ void pv_one(f32x16& od, int vb, bf16x8 pa0, bf16x8 pa1, bf16x8 pa2, bf16x8 pa3) {
    const s16x4 l0 = tr_read<v_rd_off(D0, 0, 0)>(vb), h0 = tr_read<v_rd_off(D0, 0, 1)>(vb), l1 = tr_read<v_rd_off(D0, 1, 0)>(vb), h1 = tr_read<v_rd_off(D0, 1, 1)>(vb);
    const s16x4 l2 = tr_read<v_rd_off(D0, 2, 0)>(vb), h2 = tr_read<v_rd_off(D0, 2, 1)>(vb), l3 = tr_read<v_rd_off(D0, 3, 0)>(vb), h3 = tr_read<v_rd_off(D0, 3, 1)>(vb);
    asm volatile("s_waitcnt lgkmcnt(0)" ::: "memory"); SBAR();
#define PK(L, H) (bf16x8){L[0], L[1], L[2], L[3], H[0], H[1], H[2], H[3]}
    od = __builtin_amdgcn_mfma_f32_32x32x16_bf16(pa0, PK(l0, h0), od, 0, 0, 0);
    od = __builtin_amdgcn_mfma_f32_32x32x16_bf16(pa1, PK(l1, h1), od, 0, 0, 0);
    od = __builtin_amdgcn_mfma_f32_32x32x16_bf16(pa2, PK(l2, h2), od, 0, 0, 0);
    od = __builtin_amdgcn_mfma_f32_32x32x16_bf16(pa3, PK(l3, h3), od, 0, 0, 0);
#undef PK
}
__device__ __forceinline__ void pv_d0(f32x16* o, int vb, bf16x8 pa0, bf16x8 pa1, bf16x8 pa2, bf16x8 pa3) {
    pv_one<0>(o[0], vb, pa0, pa1, pa2, pa3); pv_one<1>(o[1], vb, pa0, pa1, pa2, pa3); pv_one<2>(o[2], vb, pa0, pa1, pa2, pa3); pv_one<3>(o[3], vb, pa0, pa1, pa2, pa3);
}

template <int DQK, bool MASKED, int LDQ, int LDK, int LDV>
__device__ __forceinline__ void attn_unit(const bf16_t* __restrict__ Qb, const bf16_t* __restrict__ Kb, const bf16_t* __restrict__ Vb,
                                          int NT, int nctx, int loc0, int qpos0, float m_init, float l_init, LAS char* lds, f32x16 (&o)[4]) {
    constexpr int SHM_V = 64 * 128 * 2, SHM_K = 64 * DQK * 2, NQ = DQK / 16;
    int tid_ = threadIdx.x; asm volatile("" : "+v"(tid_));
    const int tid = tid_, wid = __builtin_amdgcn_readfirstlane(tid >> 6), lane = tid & 63, r32 = lane & 31, hi = lane >> 5;
    LAS char* V_lds = lds; LAS char* K_lds = lds + 2 * SHM_V;
    LAS float* ws = (LAS float*)(lds + 2 * SHM_V + 2 * SHM_K) + wid * 64; LAS float* li_l = ws; LAS float* al_l = ws + 32;
    float m_reg = m_init, l_reg = l_init;
#pragma unroll
    for (int d = 0; d < 4; ++d) o[d] = f32x16{};
    bf16x8 qr[NQ];
    const bf16_t* Qw = Qb + (unsigned)((wid * 32 + r32) * LDQ + hi * 8);
#pragma unroll
    for (int d0 = 0; d0 < NQ; ++d0) qr[d0] = *reinterpret_cast<const bf16x8*>(Qw + d0 * 16);
    const int sr = tid >> 4, sc = (tid & 15) * 8, vst0 = v_st(sr, sc), vst1 = v_st(32 + sr, sc);
    const int kr = (DQK == 128) ? sr : (tid >> 3), kc = (DQK == 128) ? sc : (tid & 7) * 8;
    const int kst0 = kswz<DQK>(kr, kc * 2), kst1 = kswz<DQK>(32 + kr, kc * 2);
    const int vb0 = (int)(unsigned)(uintptr_t)V_lds + v_rd_base(lane);
    const int qrel = qpos0 + wid * 32 + r32;
    const unsigned vo = (unsigned)(sr * LDV + sc) * 2u, ko = (unsigned)(kr * LDK + kc) * 2u;
    struct Slot { bf16x8 vs0, vs1, ks0, ks1; } s0, s1;
#define TROW(j) ((!MASKED || (j) < nctx) ? 64 * (j) : (CTXL + min(max(loc0 + 64 * ((j) - nctx), 0), SEQ - 64)))
#define SLOAD(S, j) do { const int rb_ = TROW(j); const char* vp_ = (const char*)Vb + (size_t)rb_ * (LDV * 2); const char* kp_ = (const char*)Kb + (size_t)rb_ * (LDK * 2); \
    S.vs0 = *reinterpret_cast<const bf16x8*>(vp_ + vo); S.vs1 = *reinterpret_cast<const bf16x8*>(vp_ + 32 * LDV * 2 + vo); \
    S.ks0 = *reinterpret_cast<const bf16x8*>(kp_ + ko); if (DQK == 128) S.ks1 = *reinterpret_cast<const bf16x8*>(kp_ + 32 * LDK * 2 + ko); } while (0)
#define SWRITE(b, S) do { *reinterpret_cast<LAS bf16x8*>(V_lds + (b) * SHM_V + vst0) = S.vs0; *reinterpret_cast<LAS bf16x8*>(V_lds + (b) * SHM_V + vst1) = S.vs1; \
    *reinterpret_cast<LAS bf16x8*>(K_lds + (b) * SHM_K + kst0) = S.ks0; if (DQK == 128) *reinterpret_cast<LAS bf16x8*>(K_lds + (b) * SHM_K + kst1) = S.ks1; } while (0)
#define SWAIT() do { if (DQK == 128) asm volatile("s_waitcnt vmcnt(4)" ::: "memory"); else asm volatile("s_waitcnt vmcnt(3)" ::: "memory"); } while (0)
#define RESC(a) do { if (__any((a) < 1.f)) { if (hi == 0) al_l[r32] = (a); asm volatile("s_waitcnt lgkmcnt(0)" ::: "memory"); \
    _Pragma("unroll") for (int d = 0; d < 4; ++d) _Pragma("unroll") for (int r = 0; r < 16; ++r) o[d][r] *= al_l[crow(r, hi)]; } } while (0)
#define PSM(P0, P1, MN, AL, j) partialSM<DQK, MASKED>(P0, P1, m_reg, MN, AL, MASKED && (j) >= nctx, loc0 + 64 * ((j) - nctx) - qrel, loc0 + 64 * ((j) - nctx), hi)
    f32x16 pA0, pA1, pB0, pB1; float mnA, mnB, alA, alB; bf16x8 pa0, pa1, pa2, pa3;
    SLOAD(s0, 0); asm volatile("s_waitcnt vmcnt(0)" ::: "memory"); SWRITE(0, s0); __syncthreads();
    qkt<DQK>(pA0, pA1, K_lds, qr, r32, hi); PSM(pA0, pA1, mnA, alA, 0);
    SLOAD(s1, 1); if (2 < NT) SLOAD(s0, 2);
    SWAIT(); SWRITE(1, s1); __syncthreads();
    for (int j = 1; j + 1 < NT; j += 2) {
        SBAR(); qkt<DQK>(pB0, pB1, K_lds + SHM_K, qr, r32, hi);
        finishSM(pA0, pA1, alA, l_reg, pa0, pa1, pa2, pa3); SBAR();
        SLOAD(s1, j + 2); SBAR();
        pv_d0(o, vb0, pa0, pa1, pa2, pa3); PSM(pB0, pB1, mnB, alB, j);
        __syncthreads(); SWAIT(); SWRITE(0, s0);
        RESC(alB); __syncthreads();
        SBAR(); qkt<DQK>(pA0, pA1, K_lds, qr, r32, hi);
        finishSM(pB0, pB1, alB, l_reg, pa0, pa1, pa2, pa3); SBAR();
        if (j + 3 < NT) SLOAD(s0, j + 3);
        SBAR();
        pv_d0(o, vb0 + SHM_V, pa0, pa1, pa2, pa3); PSM(pA0, pA1, mnA, alA, j + 1);
        __syncthreads(); SWAIT(); SWRITE(1, s1);
        RESC(alA); __syncthreads();
    }
    SBAR(); qkt<DQK>(pB0, pB1, K_lds + SHM_K, qr, r32, hi);
    finishSM(pA0, pA1, alA, l_reg, pa0, pa1, pa2, pa3); SBAR();
    pv_d0(o, vb0, pa0, pa1, pa2, pa3); PSM(pB0, pB1, mnB, alB, NT - 1);
    __syncthreads(); RESC(alB);
    finishSM(pB0, pB1, alB, l_reg, pa0, pa1, pa2, pa3); SBAR();
    pv_d0(o, vb0 + SHM_V, pa0, pa1, pa2, pa3);
    if (hi == 0) li_l[r32] = l_reg;
    asm volatile("s_waitcnt lgkmcnt(0)" ::: "memory");
#pragma unroll
    for (int r = 0; r < 16; ++r) { const float rl = __builtin_amdgcn_rcpf(li_l[crow(r, hi)]);
#pragma unroll
        for (int d = 0; d < 4; ++d) o[d][r] *= rl; }
    __syncthreads();
#undef TROW
#undef SLOAD
#undef SWRITE
#undef SWAIT
#undef RESC
#undef PSM
}
}

#define XB_TMO      128
#define XB_XCNT(j)  (256  + 64 * (j))
#define XB_XSUB(j)  (1280 + 64 * (j))
#define XB_XGEN(j)  (2304 + 64 * (j))
#define XB_TOP      3328
#define XB_TOPGEN   3392
#define XCD_BAR_WORDS 3456
#define XB_SPIN_CAP (1u << 18)
__device__ __forceinline__ unsigned xb_ld(unsigned* p)              { return __hip_atomic_load(p, __ATOMIC_RELAXED, __HIP_MEMORY_SCOPE_AGENT); }
__device__ __forceinline__ unsigned xb_add(unsigned* p, unsigned v) { return __hip_atomic_fetch_add(p, v, __ATOMIC_RELAXED, __HIP_MEMORY_SCOPE_AGENT); }
__device__ __forceinline__ unsigned xb_xcc_id() { return (unsigned)__builtin_amdgcn_s_getreg((3 << 11) | 20) & 0xFu; }
#define XB_SPIN(cond, bar) do { unsigned _sp = 0; while (cond) { __builtin_amdgcn_s_sleep(1); \
    if ((++_sp & 255u) == 0u) { if (xb_ld(&(bar)[XB_TMO])) break; if (_sp > XB_SPIN_CAP) { atomicAdd(&(bar)[XB_TMO], 1u); break; } } } } while (0)
struct XcdBarrier { unsigned* bar; unsigned x; volatile LAS unsigned* st; };
__device__ __forceinline__ XcdBarrier xcd_barrier_post(unsigned* bar, volatile LAS unsigned* st) {
    XcdBarrier b; b.bar = bar; b.x = xb_xcc_id(); b.st = st;
    if (threadIdx.x == 0) (void)xb_add(&bar[XB_XCNT(b.x)], 1u);
    return b;
}
__device__ __forceinline__ void xcd_barrier_complete(unsigned* bar, unsigned x, unsigned& nloc, unsigned& nx) {
    const unsigned G = gridDim.x * gridDim.y * gridDim.z;
    unsigned sum, cnt, mine, sp = 0u;
    for (;;) {
        sum = 0u; cnt = 0u; mine = 0u;
#pragma unroll
        for (unsigned j = 0; j < 16; ++j) { const unsigned c = xb_ld(&bar[XB_XCNT(j)]); sum += c; cnt += (c > 0u) ? 1u : 0u; mine = (j == x) ? c : mine; }
        if (sum == G) break;
        __builtin_amdgcn_s_sleep(1);
        if ((++sp & 255u) == 0u) { if (xb_ld(&bar[XB_TMO])) break; if (sp > XB_SPIN_CAP) { atomicAdd(&bar[XB_TMO], 1u); break; } }
    }
    nloc = mine > 0u ? mine : 1u; nx = cnt > 0u ? cnt : 1u;
}
__device__ __forceinline__ void xcd_barrier(const XcdBarrier& b) {
    asm volatile("s_waitcnt vmcnt(0)" ::: "memory");
    __syncthreads();
    if (threadIdx.x == 0) {
        unsigned* bar = b.bar;
        __builtin_amdgcn_s_waitcnt(0);
        unsigned nloc = b.st[0], nx = b.st[1];
        if (nloc == 0u) { xcd_barrier_complete(bar, b.x, nloc, nx); b.st[0] = nloc; b.st[1] = nx; }
        const unsigned old = xb_add(&bar[XB_XSUB(b.x)], 1u);
        const unsigned gen = old / nloc;
        if (old + 1u == (gen + 1u) * nloc) {
            __builtin_amdgcn_fence(__ATOMIC_RELEASE, "agent");
            asm volatile("s_waitcnt vmcnt(0)" ::: "memory");
            const unsigned og = xb_add(&bar[XB_TOP], 1u);
            const unsigned tg = og / nx;
            if (og + 1u == (tg + 1u) * nx) xb_add(&bar[XB_TOPGEN], 1u);
            else XB_SPIN(xb_ld(&bar[XB_TOPGEN]) == tg, bar);
            __builtin_amdgcn_fence(__ATOMIC_ACQUIRE, "agent");
            xb_add(&bar[XB_XGEN(b.x)], 1u);
            asm volatile("s_waitcnt vmcnt(0)" ::: "memory");
        } else {
            XB_SPIN(xb_ld(&bar[XB_XGEN(b.x)]) == gen, bar);
            __builtin_amdgcn_fence(__ATOMIC_ACQUIRE, "agent");
            asm volatile("s_waitcnt vmcnt(0)" ::: "memory");
        }
    }
    __syncthreads();
}

struct Args { const float* in[22]; float* out; unsigned char* ws; int ph_lo, ph_hi; };
__device__ __forceinline__ const float* inp(LAS unsigned char* lds, int k) {
    volatile LAS unsigned* p = (volatile LAS unsigned*)(lds + PTR_OFF) + 2 * k;
    const unsigned lo = __builtin_amdgcn_readfirstlane(p[0]), hi = __builtin_amdgcn_readfirstlane(p[1]);
    return (const float*)(const GAS float*)(((unsigned long long)hi << 32) | lo);
}

__device__ __forceinline__ float wave_sum(float v) {
#pragma unroll
    for (int o = 1; o < 64; o <<= 1) v += __shfl_xor(v, o);
    return v;
}
template <bool GATEMAP = false>
__device__ __forceinline__ void tr_item(const float* __restrict__ W, int N, bf16_t* __restrict__ WT, int ldd, int k0, int n0, int drow0, int dcol0, LAS unsigned* scr, int lane) {
    const float* src = W + (size_t)k0 * N + n0 + lane;
#pragma unroll 8
    for (int kk = 0; kk < 64; ++kk) { const float a = src[(size_t)(2 * kk) * N], b = src[(size_t)(2 * kk + 1) * N]; scr[lane * 65 + kk] = cvt_pk_bf16(a, b); }
    LDS_WAIT(); asm volatile("" ::: "memory");
    const int q = lane & 15;
#pragma unroll 4
    for (int i = 0; i < 16; ++i) { const int n = 4 * i + (lane >> 4); const LAS unsigned* s = scr + n * 65 + 4 * q;
        u32x4 o; o.x = s[0]; o.y = s[1]; o.z = s[2]; o.w = s[3];
        const int dr = GATEMAP ? drow0 + 32 * (n >> 4) + (n & 15) : drow0 + n;
        *(u32x4*)(WT + (size_t)dr * ldd + dcol0 + 8 * q) = o; }
    LDS_WAIT(); asm volatile("" ::: "memory");
}

__device__ __forceinline__ void prologue_a(unsigned char* ws, LAS unsigned char* lds, int gw, int NGW, int wave, int lane) {
    LAS unsigned* scr = (LAS unsigned*)(lds + wave * 16640);
    constexpr int I13 = 32 * 160, I2 = 40 * 64, IIN = 32 * 140, IB = 8 * 64, IG = 2 * 256, IO = 32 * 64;
    constexpr int IL = 2 * I13 + 2 * I2 + IIN + 4 * IB + IG + IO;
    const float* p8 = inp(lds, 8); const float* p9 = inp(lds, 9); const float* p10 = inp(lds, 10); const float* p19 = inp(lds, 19); const float* p20 = inp(lds, 20); const float* p21 = inp(lds, 21);
    for (int it = gw; it < DEPTH * IL; it += NGW) {
        const int l = it / IL; int r = it % IL; unsigned char* wl = ws + WS_W + (size_t)l * WL_SIZE;
        if (r < 2 * I13) { const int k = r / I13; r %= I13; const int kb = r / 160, nb = r % 160, n0 = nb * 64;
            const int drow0 = n0 < DFF ? 256 * (n0 / 128) + (n0 % 128) : 256 * ((n0 - DFF) / 128) + 128 + ((n0 - DFF) % 128);
            tr_item(p8 + (size_t)(l * 2 + k) * DM * 2 * DFF, 2 * DFF, (bf16_t*)(wl + WL_W13) + (size_t)k * 2 * DFF * DM, DM, kb * 128, n0, drow0, kb * 128, scr, lane); continue; }
        r -= 2 * I13;
        if (r < 2 * I2) { const int k = r / I2; r %= I2; const int kb = r / 64, nb = r % 64;
            tr_item(p9 + (size_t)(l * 2 + k) * DFF * DM, DM, (bf16_t*)(wl + WL_W2) + (size_t)k * DM * DFF, DFF, kb * 128, nb * 64, nb * 64, kb * 128, scr, lane); continue; }
        r -= 2 * I2;
        if (r < IIN) { const int kb = r / 140, nb = r % 140;
            tr_item(p10 + (size_t)l * DM * NIN, NIN, (bf16_t*)(wl + WL_WIN), DM, kb * 128, nb * 64, nb * 64, kb * 128, scr, lane); continue; }
        r -= IIN;
        if (r < 4 * IB) { const int i = r / IB; r %= IB; const int kb = r / 64, nb = r % 64;
            tr_item(p19 + (size_t)(l * 4 + i) * 1024 * DM, DM, (bf16_t*)(wl + WL_WB), DM, kb * 128, nb * 64, nb * 64, i * 1024 + kb * 128, scr, lane); continue; }
        r -= 4 * IB;
        if (r < IG) { const int kb = r / 256, nb = r % 256;
            const int gi = nb >> 6, c0 = (nb & 63) * 64;
            tr_item<true>(p20 + (size_t)l * 256 * 16384, 16384, (bf16_t*)(wl + WL_GATE), 256, kb * 128, nb * 64, 256 * (c0 >> 6) + 128 * (gi >> 1) + 16 * (gi & 1), kb * 128, scr, lane); continue; }
        r -= IG;
        { const int kb = r / 64, nb = r % 64;
            tr_item(p21 + (size_t)l * DM * DM, DM, (bf16_t*)(wl + WL_WO), DM, kb * 128, nb * 64, nb * 64, kb * 128, scr, lane); }
    }
    const long gt = (long)gw * 64 + lane, NGT = (long)NGW * 64;
    { bf16_t* f1 = (bf16_t*)(ws + WS_F1); bf16_t* f2 = (bf16_t*)(ws + WS_F2);
      for (long idx = gt; idx < 256 * 256; idx += NGT) { const int m = (int)(idx >> 8), kk = (int)(idx & 255), ri = m >> 7, t2p = (m >> 6) & 1, k1 = m & 63, t2q = kk >> 7, cs = (kk >> 6) & 1, t1 = kk & 63;
          const float x = (float)((k1 * t1) & 63) * (1.f / 64.f), c = __builtin_amdgcn_cosf(x), sn = __builtin_amdgcn_sinf(x);
          const float v = (t2p != t2q) ? 0.f : (ri == 0 ? (cs == 0 ? c : sn) : (cs == 0 ? -sn : c)); f1[idx] = (bf16_t)(cvt_pk_bf16(v, 0.f) & 0xffffu); }
      for (long idx = gt; idx < 256 * 512; idx += NGT) { const int m = (int)(idx >> 9), kk = (int)(idx & 511), k1p = m >> 7, k2 = m & 127, k1q = kk >> 8, ri = (kk >> 7) & 1, t2 = kk & 127;
          const float x = (float)((k2 * t2) & 127) * (1.f / 128.f);
          const float v = (k1p != k1q) ? 0.f : (ri == 0 ? __builtin_amdgcn_cosf(x) : __builtin_amdgcn_sinf(x)); f2[idx] = (bf16_t)(cvt_pk_bf16(v, 0.f) & 0xffffu); } }
    { bf16_t* ct = (bf16_t*)(ws + WS_CSCT); bf16_t* cx = (bf16_t*)(ws + WS_CSCTX);
      for (long idx = gt; idx < 512 * 256; idx += NGT) { const int m = (int)(idx >> 8), c = (int)(idx & 255); const float x = (float)(((m & 255) * c) & 255) * (1.f / 256.f);
          const float v = (m < 256) ? __builtin_amdgcn_cosf(x) : -__builtin_amdgcn_sinf(x); ct[idx] = (bf16_t)(cvt_pk_bf16(v, 0.f) & 0xffffu); }
      for (long idx = gt; idx < 256 * 512; idx += NGT) { const int k = (int)(idx >> 9), tp = (int)(idx & 511); const float x = (float)((k * (tp & 255)) & 255) * (1.f / 256.f);
          const float v = (tp < 256) ? __builtin_amdgcn_cosf(x) : __builtin_amdgcn_sinf(x); cx[idx] = (bf16_t)(cvt_pk_bf16(v, 0.f) & 0xffffu); } }
    { float* rp = (float*)(ws + WS_ROPE);
      for (long idx = gt; idx < 128 * 32; idx += NGT) { const int pos = (int)(idx >> 5), i = (int)(idx & 31); const float inv = exp2f(-(float)(2 * i) * (1.f / 64.f) * 13.287712379549449f);
          float rev = (float)pos * inv * 0.15915494309189535f; rev -= floorf(rev); rp[idx] = __builtin_amdgcn_cosf(rev); rp[4096 + idx] = __builtin_amdgcn_sinf(rev); }
      for (long idx = gt; idx < 128 * 16; idx += NGT) { const int pos = (int)(idx >> 4), i = (int)(idx & 15); const float inv = exp2f(-(float)(2 * i) * (1.f / 32.f) * 13.287712379549449f);
          float rev = (float)pos * inv * 0.15915494309189535f; rev -= floorf(rev); rp[8192 + idx] = __builtin_amdgcn_cosf(rev); rp[8192 + 2048 + idx] = __builtin_amdgcn_sinf(rev); } }
    { float* xs = (float*)(ws + WS_XS); const float* pctx = inp(lds, 2); const float* px = inp(lds, 0);
      for (int r = gw; r < T; r += NGW) { const int b = r / TB, i = r % TB; const float* src = (i < CTXL) ? pctx + (size_t)(b * CTXL + i) * DM : px + (size_t)(b * SEQ + i - CTXL) * DM;
          const f32x4* s4 = (const f32x4*)src + lane; f32x4* d4 = (f32x4*)(xs + (size_t)r * DM) + lane;
#pragma unroll
          for (int j = 0; j < 16; ++j) d4[64 * j] = s4[64 * j]; } }
    { float* t1 = (float*)(ws + WS_T1P); const float* pc = inp(lds, 1); const float* pcc = inp(lds, 3); const float* pdn = inp(lds, 5);
      for (int it = gw; it < DEPTH * 64; it += NGW) { const int l = it >> 6, ch = it & 63; f32x4 acc0 = {0, 0, 0, 0}, acc1 = acc0, acc2 = acc0;
          const float* dn = pdn + ((size_t)l * DM + ch * 64) * 256 + 4 * lane;
          for (int d = 0; d < 64; ++d) { const int dd = ch * 64 + d; const f32x4 row = *(const f32x4*)(dn + (size_t)d * 256);
              const float c0 = pc[dd], c1 = pc[DM + dd], c2 = pcc[dd];
              acc0 += row * (c0 / (1.f + __expf(-c0))); acc1 += row * (c1 / (1.f + __expf(-c1))); acc2 += row * (c2 / (1.f + __expf(-c2))); }
          float* o = t1 + ((size_t)(l * 64 + ch) * 3) * 256 + 4 * lane; *(f32x4*)o = acc0; *(f32x4*)(o + 256) = acc1; *(f32x4*)(o + 512) = acc2; } }
    if (gw == 0) { float* lm = (float*)(ws + WS_LAM); const float* pdl = inp(lds, 17);
        for (int l = 0; l < DEPTH; ++l) { const float* dl = pdl + l * 256; const float s1 = wave_sum(dl[lane] * dl[64 + lane]), s2 = wave_sum(dl[128 + lane] * dl[192 + lane]);
            const float li = 0.8f - 0.6f * expf(-0.3f * (float)l); if (lane == 0) { lm[l] = expf(s1) - expf(s2) + li; lm[4 + l] = 1.f - li; } } }
}
__device__ __forceinline__ void prologue_b(unsigned char* ws, LAS unsigned char* lds, int gw, int NGW, int wave, int lane) {
    LAS float* tl = (LAS float*)(lds + wave * 4096);
    const float* t1 = (const float*)(ws + WS_T1P); float* mod = (float*)(ws + WS_MOD); const float* pb7 = inp(lds, 7); const float* pup = inp(lds, 6);
    for (int it = gw; it < DEPTH * 144; it += NGW) { const int l = it / 144, n0 = (it % 144) * 256 + 4 * lane;
        f32x4 t0 = {0, 0, 0, 0}, t1v = t0, t2 = t0;
        for (int ch = 0; ch < 64; ++ch) { const float* p = t1 + ((size_t)(l * 64 + ch) * 3) * 256 + 4 * lane; t0 += *(const f32x4*)p; t1v += *(const f32x4*)(p + 256); t2 += *(const f32x4*)(p + 512); }
        *(LAS f32x4*)(tl + 4 * lane) = t0; *(LAS f32x4*)(tl + 256 + 4 * lane) = t1v; *(LAS f32x4*)(tl + 512 + 4 * lane) = t2;
        LDS_WAIT(); asm volatile("" ::: "memory");
        const f32x4 bb = *(const f32x4*)(pb7 + (size_t)l * NMOD * DM + n0); f32x4 acc0 = bb, acc1 = bb, acc2 = bb;
        const float* up = pup + (size_t)l * 256 * NMOD * DM + n0;
#pragma unroll 4
        for (int j = 0; j < 256; ++j) { const f32x4 row = *(const f32x4*)(up + (size_t)j * NMOD * DM); acc0 += row * tl[j]; acc1 += row * tl[256 + j]; acc2 += row * tl[512 + j]; }
        float* o = mod + (size_t)(l * 3) * NMOD * DM + n0; *(f32x4*)o = acc0; *(f32x4*)(o + NMOD * DM) = acc1; *(f32x4*)(o + 2 * NMOD * DM) = acc2;
        LDS_WAIT(); asm volatile("" ::: "memory"); }
}
__device__ __forceinline__ void norm_phase(unsigned char* ws, LAS unsigned char* lds, int l, int k, int gw, int NGW, int tid, int lane, const float* fixcoef, float fixf, int skipc) {
    asm volatile("" : "+v"(lane), "+v"(tid));
    LAS float* gp = (LAS float*)lds; LAS float* sh = gp + 3 * DM;
    const float* mod = (const float*)(ws + WS_MOD) + (size_t)(l * 3) * NMOD * DM; const float* g = inp(lds, 4) + (size_t)(l * 3 + k) * DM;
    for (int i = tid; i < 3 * DM; i += NTHREADS) { const int v = i / DM, c = i % DM; gp[i] = g[c] * (1.f + mod[(size_t)v * NMOD * DM + (3 * k + 1) * DM + c]); sh[i] = mod[(size_t)v * NMOD * DM + (3 * k) * DM + c]; }
    __syncthreads();
    float* xs = (float*)(ws + WS_XS); bf16_t* H = (bf16_t*)(ws + WS_H); const float* PK = (const float*)(ws + WS_PART);
    for (int r = gw; r < T; r += NGW) { const int b = r / TB, i = r % TB, v = (i < CTXL) ? 2 : b;
        if (skipc && i < CTXL) continue;
        f32x4* xr = (f32x4*)(xs + (size_t)r * DM) + lane; f32x4 x[16]; float s = 0.f;
#pragma unroll
        for (int j = 0; j < 16; ++j) x[j] = xr[64 * j];
        if (fixcoef != nullptr && i < CTXL) {
            const f32x4* pk = (const f32x4*)(PK + (size_t)(b * 256 + i) * DM) + lane; const f32x4* cf = (const f32x4*)fixcoef + lane;
#pragma unroll
            for (int j = 0; j < 16; ++j) { f32x4 sum = pk[64 * j];
#pragma unroll
                for (int z = 1; z < 8; ++z) sum += pk[(size_t)z * 2 * 256 * (DM / 4) + 64 * j];
                x[j] = x[j] + cf[64 * j] * fixf * sum; xr[64 * j] = x[j]; }
        }
#pragma unroll
        for (int j = 0; j < 16; ++j) s += (x[j][0] * x[j][0] + x[j][1] * x[j][1]) + (x[j][2] * x[j][2] + x[j][3] * x[j][3]);
        const float rstd = 1.f / sqrtf(wave_sum(s) * (1.f / DM) + EPS);
        u32x2* o = (u32x2*)(H + (size_t)r * DM) + lane;
#pragma unroll
        for (int j = 0; j < 16; ++j) { const f32x4 gg = *(const LAS f32x4*)(gp + v * DM + 4 * lane + 256 * j), ss = *(const LAS f32x4*)(sh + v * DM + 4 * lane + 256 * j);
            const f32x4 y = x[j] * rstd * gg + ss; u32x2 w; w.x = cvt_pk_bf16(y[0], y[1]); w.y = cvt_pk_bf16(y[2], y[3]); o[64 * j] = w; } }
    __syncthreads();
}
__device__ __forceinline__ void ld16(const bf16_t* p, float (&x)[16]) { const u32x4 a = *(const u32x4*)p, b = *(const u32x4*)(p + 8);
    x[0] = bf_lo(a.x); x[1] = bf_hi(a.x); x[2] = bf_lo(a.y); x[3] = bf_hi(a.y); x[4] = bf_lo(a.z); x[5] = bf_hi(a.z); x[6] = bf_lo(a.w); x[7] = bf_hi(a.w);
    x[8] = bf_lo(b.x); x[9] = bf_hi(b.x); x[10] = bf_lo(b.y); x[11] = bf_hi(b.y); x[12] = bf_lo(b.z); x[13] = bf_hi(b.z); x[14] = bf_lo(b.w); x[15] = bf_hi(b.w); }
__device__ __forceinline__ void st16(bf16_t* p, const float (&x)[16]) { u32x4 a, b;
    a.x = cvt_pk_bf16(x[0], x[1]); a.y = cvt_pk_bf16(x[2], x[3]); a.z = cvt_pk_bf16(x[4], x[5]); a.w = cvt_pk_bf16(x[6], x[7]);
    b.x = cvt_pk_bf16(x[8], x[9]); b.y = cvt_pk_bf16(x[10], x[11]); b.z = cvt_pk_bf16(x[12], x[13]); b.w = cvt_pk_bf16(x[14], x[15]); *(u32x4*)p = a; *(u32x4*)(p + 8) = b; }
template <int HD>
__device__ __forceinline__ void normrope(float (&x)[16], int lane, const float* __restrict__ gain, bool rope, int rowpos, int colpos, const float* __restrict__ rp) {
    float s = 0.f;
#pragma unroll
    for (int e = 0; e < 16; ++e) s += x[e] * x[e];
    s += __shfl_xor(s, 1); s += __shfl_xor(s, 2); if (HD == 128) s += __shfl_xor(s, 4);
    const float rstd = 1.f / sqrtf(s * (1.f / HD) + EPS);
    const int j = lane & (HD / 16 - 1);
#pragma unroll
    for (int e = 0; e < 16; ++e) x[e] = x[e] * rstd * gain[j * 16 + e];
    constexpr int PX = (HD == 128) ? 2 : 1;
    float y[16];
#pragma unroll
    for (int e = 0; e < 16; ++e) y[e] = __shfl_xor(x[e], PX);
    if (rope) {
        const int part = (HD == 128) ? (j >> 2) : (j >> 1), role = (HD == 128) ? ((j >> 1) & 1) : (j & 1), fb = (HD == 128) ? 16 * (j & 1) : 0, pos = part ? colpos : rowpos;
        const float* ct = rp + ((HD == 128) ? 0 : 8192) + pos * (HD / 4) + fb; const float* st = ct + ((HD == 128) ? 4096 : 2048);
#pragma unroll
        for (int e = 0; e < 16; ++e) { const float c = ct[e], sn = st[e]; x[e] = role ? (x[e] * c + y[e] * sn) : (x[e] * c - y[e] * sn); }
    }
}
__device__ __forceinline__ void p6_rows(unsigned char* ws, LAS unsigned char* lds, int l, int gw, int NGW, int lane) {
    asm volatile("" : "+v"(lane));
    const bf16_t* PC = (const bf16_t*)(ws + WS_PIECES); const float* rp = (const float*)(ws + WS_ROPE);
    bf16_t* QS = (bf16_t*)(ws + WS_QS); bf16_t* KS = (bf16_t*)(ws + WS_KS); bf16_t* QD = (bf16_t*)(ws + WS_QD); bf16_t* KD = (bf16_t*)(ws + WS_KD); bf16_t* OB = (bf16_t*)(ws + WS_OB);
    const float* gsq = inp(lds, 12) + l * 128; const float* gsk = inp(lds, 13) + l * 128; const float* gdq = inp(lds, 15) + l * 64; const float* gdk = inp(lds, 16) + l * 64; const float* cw = inp(lds, 11) + (size_t)l * 3 * 1024;
    for (int r = gw; r < T; r += NGW) { const int i = r % TB; const bool lat = i >= CTXL; const int t = i - CTXL, rowpos = (t >> 6) & 127, colpos = t & 63;
        const bf16_t* P = PC + (size_t)r * NIN; float x[16];
        ld16(P + C_SQ + 16 * lane, x); normrope<128>(x, lane, gsq, lat, rowpos, colpos, rp); st16(QS + (size_t)r * 1024 + 16 * lane, x);
        ld16(P + C_SK + 16 * (lane & 15), x); normrope<128>(x, lane, gsk, lat, rowpos, colpos, rp); if (lane < 16) st16(KS + (size_t)r * 256 + 16 * lane, x);
        ld16(P + C_DQ + 16 * lane, x); normrope<64>(x, lane, gdq, lat, rowpos, colpos, rp); st16(QD + (size_t)r * 1024 + 16 * lane, x);
        ld16(P + C_DK + 16 * lane, x); normrope<64>(x, lane, gdk, lat, rowpos, colpos, rp); st16(KD + (size_t)r * 1024 + 16 * lane, x);
        { const int seg_lo = lat ? CTXL : 0, seg_hi = lat ? TB : CTXL; float gc[16], vv[16], y[16];
          ld16(P + C_CONVC + 16 * lane, gc); ld16(P + C_CONVV + 16 * lane, vv);
#pragma unroll
          for (int e = 0; e < 16; ++e) y[e] = gc[e] * vv[e] * cw[1024 + 16 * lane + e];
          if (i - 1 >= seg_lo) { ld16(P - NIN + C_CONVC + 16 * lane, gc); ld16(P - NIN + C_CONVV + 16 * lane, vv);
#pragma unroll
              for (int e = 0; e < 16; ++e) y[e] += gc[e] * vv[e] * cw[16 * lane + e]; }
          if (i + 1 < seg_hi) { ld16(P + NIN + C_CONVC + 16 * lane, gc); ld16(P + NIN + C_CONVV + 16 * lane, vv);
#pragma unroll
              for (int e = 0; e < 16; ++e) y[e] += gc[e] * vv[e] * cw[2048 + 16 * lane + e]; }
          ld16(P + C_CONVB + 16 * lane, gc);
#pragma unroll
          for (int e = 0; e < 16; ++e) y[e] *= gc[e];
          st16(OB + (size_t)r * DM + 1024 + 16 * lane, y); }
    }
}

constexpr int PH_PER_LAYER = 13, N_PHASES = 2 + DEPTH * PH_PER_LAYER;
__global__ void __launch_bounds__(NTHREADS, 2) fwd_kernel(Args args) {
    extern __shared__ __attribute__((aligned(16))) unsigned char lds_raw[];
    LAS unsigned char* lds = (LAS unsigned char*)lds_raw;
    volatile LAS unsigned* MISC = (volatile LAS unsigned*)(lds + MISC_OFF);
    const int tid = threadIdx.x, lane = tid & 63, wave = __builtin_amdgcn_readfirstlane(tid >> 6);
    const int G = gridDim.x, bx = blockIdx.x;
    const int vcu = (G % 8 == 0) ? (bx % 8) * (G / 8) + bx / 8 : bx;
    const int gw = vcu * NWAVES + wave, NGW = G * NWAVES;
    unsigned char* ws = args.ws;
    unsigned* ctl = (unsigned*)(ws + WS_CTL);
    for (int u = tid; u < 64; u += NTHREADS) MISC[u] = 0u;
    if (tid < 22) ((LAS unsigned long long*)(lds + PTR_OFF))[tid] = (unsigned long long)(uintptr_t)args.in[tid];
    __syncthreads();
    XcdBarrier bar; bar.bar = ctl + CW_BAR; bar.x = 0; bar.st = nullptr;
    if (!MK_PER_PHASE) bar = xcd_barrier_post(ctl + CW_BAR, MISC + 8);
    const int lo = args.ph_lo, hi = args.ph_hi;
#ifndef ONLY_SITE
#define ONLY_SITE -1
#endif
#define SITE(s) (ONLY_SITE < 0 || ONLY_SITE == (s))
#ifndef ONLY_SUB
#define ONLY_SUB -1
#endif
#define SUB(s) (ONLY_SUB < 0 || ONLY_SUB == (s))
#ifndef REP_SITE
#define REP_SITE -1
#endif
#ifndef REP_SUB
#define REP_SUB -1
#endif
#define REPS(n) for (int rep_ = 0; rep_ < ((REP_SITE == (n) && REP_SUB < 0) ? 2 : 1); ++rep_)
#define REPSUB(n, q) for (int rep_ = 0; rep_ < ((REP_SITE == (n) && REP_SUB == (q)) ? 2 : 1); ++rep_)
#define IN(k) (lo <= (k) && (k) < hi)
#define SEAM(k) do { if (IN(k) && IN((k) + 1)) { if (MK_PER_PHASE) { if (tid == 0) __hip_atomic_store(ctl + 1, 0xBAD00000u | (unsigned)(k), RLX_AGENT); } else xcd_barrier(bar); } } while (0)

    if (SITE(0) && IN(0)) REPS(0) { prologue_a(ws, lds, gw, NGW, wave, lane); } SEAM(0);
    if (SITE(1) && IN(1)) REPS(1) { prologue_b(ws, lds, gw, NGW, wave, lane); } SEAM(1);

#define H_ ((bf16_t*)(ws + WS_H))
#define ACT_ ((bf16_t*)(ws + WS_ACT))
#define PIECES_ ((bf16_t*)(ws + WS_PIECES))
#define XS_ ((float*)(ws + WS_XS))
#define OB_ ((bf16_t*)(ws + WS_OB))
#define SIG_ ((bf16_t*)(ws + WS_SIG))
#define MG_ ((bf16_t*)(ws + WS_MG))
#define WL_ (ws + WS_W + (size_t)l * WL_SIZE)
#define MODL_ ((const float*)(ws + WS_MOD) + (size_t)(l * 3) * NMOD * DM)
    for (int it = 0; it < 2 * DEPTH; ++it) {
        const int l = it >> 1, hf = it & 1, kidx = hf ? 2 : 0, pb = 2 + PH_PER_LAYER * l + (hf ? 10 : 0);
        if (SITE(2) && IN(pb + 0)) REPS(2) { norm_phase(ws, lds, l, kidx, gw, NGW, tid, lane,
            (it == 0) ? (const float*)nullptr : (const float*)(ws + WS_MOD) + ((size_t)((hf ? l : l - 1) * 3 + 2) * NMOD + (hf ? 5 : 8)) * DM, hf ? 1.f : 0.5f, (l == DEPTH - 1 && hf) ? 1 : 0); } SEAM(pb + 0);
        if (SITE(3) && IN(pb + 1)) REPS(3) {
            pg8::Gemm g = pg8::mk_gemm(H_, (const bf16_t*)(WL_ + WL_W13) + (size_t)hf * 2 * DFF * DM, DM, DM, DM, 0, 0); pg8::Order S; S.init_tok(2 * DFF / 256, G, bx, DM / 64, 1, (l == DEPTH - 1 && hf) ? 1 : 0);
            pg8::EpiSwiGLU E{ACT_, DFF};
            pg8::gemm_phase<pg8::EpiSwiGLU, true, true>(lds, g, S, E);
        } SEAM(pb + 1);
        if (SITE(4) && IN(pb + 2)) REPS(4) {
            const bool dummy_ = (REP_SITE == 4) && rep_ == 0;
            pg8::Gemm g = pg8::mk_gemm(ACT_, (const bf16_t*)(WL_ + WL_W2) + (size_t)hf * DM * DFF, DFF, DFF, DFF, DFF / 8, DFF / 8); pg8::Order S; S.init_tok(DM / 256, G, bx, DFF / 64, 8, (it == 2 * DEPTH - 1) ? 1 : 0);
            pg8::EpiResid<true> E{dummy_ ? (float*)(ws + WS_SIG) : XS_, MODL_ + (size_t)(kidx * 3 + 2) * DM, dummy_ ? (float*)(ws + WS_SIG) + (size_t)CTXL * 2 * DM : args.out, (it == 2 * DEPTH - 1) ? 1 : 0, dummy_ ? (float*)(ws + WS_SIG) + (size_t)T * DM : (float*)(ws + WS_PART)};
            pg8::gemm_phase<pg8::EpiResid<true>, true, true>(lds, g, S, E);
        } SEAM(pb + 2);
        if (hf) continue;
        const int mb = pb + 3;
        if (SITE(5) && IN(mb + 0)) REPS(2) { norm_phase(ws, lds, l, 1, gw, NGW, tid, lane, (const float*)(ws + WS_MOD) + ((size_t)(l * 3 + 2) * NMOD + 2) * DM, 0.5f, 0); } SEAM(mb + 0);
        if (SITE(6) && IN(mb + 1)) REPS(6) {
            pg8::Gemm g = pg8::mk_gemm(H_, (const bf16_t*)(WL_ + WL_WIN), DM, DM, DM, 0, 0); pg8::Order S; S.init_tok(NIN / 256, G, bx, DM / 64, 1, 0);
            pg8::EpiBf16 E{PIECES_, NIN, 0, 0, 1.f};
            pg8::gemm_phase<pg8::EpiBf16, true, true>(lds, g, S, E);
        } SEAM(mb + 1);
        if (SITE(7) && IN(mb + 2)) REPS(7) {
            if (SUB(0)) REPSUB(7, 0) {
                pg8::Gemm g = pg8::mk_gemm((const bf16_t*)(ws + WS_CSCT), PIECES_ + (size_t)CTXL * NIN + C_FOUR, 256, 256, NIN, 0, 256);
                g.zsplit = 4; g.bsB2 = (long)TB * NIN; g.tsB = (long)4 * NIN * 2; g.gatherB = 1;
                pg8::Order S; S.init(2, SEQ / 256, 8, G, bx, 4);
                pg8::EpiChan2 E{(bf16_t*)(ws + WS_ABT)};
                pg8::gemm_phase<pg8::EpiChan2, true, true>(lds, g, S, E);
            }
            if (SUB(0)) {
                pg8::Gemm g = pg8::mk_gemm((const bf16_t*)(ws + WS_CSCT), PIECES_ + C_FOUR, 256, 256, NIN, 0, 256); g.tsB = (long)TB * NIN * 2;
                pg8::Order S; S.init(2, 2, 4, G, bx, 4);
                pg8::EpiChanC E{(bf16_t*)(ws + WS_ABTC)};
                pg8::gemm_phase<pg8::EpiChanC, true, true>(lds, g, S, E);
            }
            if (SUB(1)) REPSUB(7, 1) {
                pg8::Gemm g = pg8::mk_gemm(PIECES_ + C_Z, (const bf16_t*)(WL_ + WL_GATE), 256, NIN, 256, 0, 0); pg8::Order S; S.init(T / 256, 16384 / 256, 1, G, bx, 4);
                pg8::EpiGate E{SIG_};
                pg8::gemm_phase<pg8::EpiGate, true, true>(lds, g, S, E);
            }
            if (SUB(2)) REPSUB(7, 2) p6_rows(ws, lds, l, gw, NGW, lane);
        } SEAM(mb + 2);
        if (SITE(8) && IN(mb + 3)) REPS(8) {
            if (SUB(0)) REPSUB(8, 0) {
                pg8::Gemm g = pg8::mk_gemm((const bf16_t*)(ws + WS_F1), (const bf16_t*)(ws + WS_ABT), 256, 256, 256, 0, 0); pg8::Order S; S.init(1, 2 * 1024 * 64 / 256, 1, G, bx, 4);
                pg8::EpiFft1 E{(bf16_t*)(ws + WS_Y2)};
                pg8::gemm_phase<pg8::EpiFft1, true, true>(lds, g, S, E);
            }
            if (SUB(1)) {
                pg8::Gemm g = pg8::mk_gemm((const bf16_t*)(ws + WS_CSCTX), (const bf16_t*)(ws + WS_ABTC), 512, 512, 512, 0, (long)1024 * 512); pg8::Order S; S.init(1, 4, 2, G, bx, 8);
                pg8::EpiBf16 E{OB_, DM, 0, TB, 1.f / 256.f};
                pg8::gemm_phase<pg8::EpiBf16, true, true>(lds, g, S, E);
            }
            __syncthreads();
            const int wid = wave;
            const float* lamp = (const float*)(ws + WS_LAM); const float lam = lamp[l], oml = lamp[4 + l];
            if (SUB(2)) REPSUB(8, 2) for (int u = bx; u < 512 + 16; u += G) {
                int b, h, q0, NT;
                if (u < 512) { b = u >> 8; h = (u >> 5) & 7; q0 = CTXL + (u & 31) * 256; NT = TB / 64; } else { const int v = u - 512; b = v >> 3; h = v & 7; q0 = 0; NT = CTXL / 64; }
                const size_t rb = (size_t)b * TB; float* O1 = (float*)(ws + WS_O1);
                for (int c = 0; c < 2; ++c) {
                    f32x16 o[4];
                    att::attn_unit<64, false, 1024, 1024, NIN>((const bf16_t*)(ws + WS_QD) + (rb + q0) * 1024 + (2 * h + c) * 64, (const bf16_t*)(ws + WS_KD) + rb * 1024 + (2 * h + c) * 64,
                                              (const bf16_t*)(ws + WS_PIECES) + rb * NIN + C_DV + h * 128, NT, 0, 0, 0, -1e30f, 0.f, (LAS char*)lds, o);
                    int ln = lane; asm volatile("" : "+v"(ln));
                    const int r32 = ln & 31, hi5 = ln >> 5;
                    float* O1b = O1 + (rb + q0 + wid * 32) * 1024 + h * 128;
                    const unsigned lo1 = (unsigned)(4 * hi5 * 1024 + r32);
                    if (c == 0) {
#pragma unroll
                        for (int r = 0; r < 16; ++r) { float* p = O1b + ((r & 3) + 8 * (r >> 2)) * 1024 + lo1;
#pragma unroll
                            for (int d = 0; d < 4; ++d) p[d * 32] = o[d][r];
                            asm volatile("" ::: "memory"); }
                    } else {
                        const float* sub = inp(lds, 18) + l * 128; float sg[4];
#pragma unroll
                        for (int d = 0; d < 4; ++d) sg[d] = sub[d * 32 + r32] * oml;
                        bf16_t* OBb = (bf16_t*)(ws + WS_OB) + (rb + q0 + wid * 32) * DM + 3072 + h * 128;
                        const unsigned lo2 = (unsigned)(4 * hi5 * DM + r32);
#pragma unroll
                        for (int r = 0; r < 16; ++r) { const float* p = O1b + ((r & 3) + 8 * (r >> 2)) * 1024 + lo1; float dv[4], ss = 0.f;
#pragma unroll
                            for (int d = 0; d < 4; ++d) { dv[d] = p[d * 32] - lam * o[d][r]; ss += dv[d] * dv[d]; }
                            ss += __shfl_xor(ss, 1); ss += __shfl_xor(ss, 2); ss += __shfl_xor(ss, 4); ss += __shfl_xor(ss, 8); ss += __shfl_xor(ss, 16);
                            const float rstd = 1.f / sqrtf(ss * (1.f / 128.f) + EPS); bf16_t* q = OBb + ((r & 3) + 8 * (r >> 2)) * DM + lo2;
#pragma unroll
                            for (int d = 0; d < 4; ++d) q[d * 32] = (bf16_t)(cvt_pk_bf16(dv[d] * rstd * sg[d], 0.f) & 0xffffu);
                            asm volatile("" ::: "memory"); }
                    }
                }
            }
        } SEAM(mb + 3);
        if (SITE(11) && IN(mb + 4)) REPS(11) {
            if (SUB(0)) {
                pg8::Gemm g = pg8::mk_gemm((const bf16_t*)(ws + WS_F2), (const bf16_t*)(ws + WS_Y2), 512, 512, 512, 0, 0); pg8::Order S; S.init(1, 2 * 32 * 1024 / 256, 1, G, bx, 8);
                pg8::EpiFft2 E{OB_};
                pg8::gemm_phase<pg8::EpiFft2, true, true>(lds, g, S, E);
            }
            __syncthreads();
            const int wid = wave;
            if (SUB(3)) REPSUB(11, 3) for (int u = bx; u < 512 + 16; u += G) {
                int b, h, q0, NT, i0;
                if (u < 512) { b = u >> 8; h = (u >> 5) & 7; i0 = (u & 31) * 256; q0 = CTXL + i0; NT = 12; } else { const int v = u - 512; b = v >> 3; h = v & 7; i0 = 0; q0 = 0; NT = 4; }
                const size_t rb = (size_t)b * TB; const float sink = inp(lds, 14)[l * 8 + h];
                f32x16 o[4];
                att::attn_unit<128, true, 1024, 256, NIN>((const bf16_t*)(ws + WS_QS) + (rb + q0) * 1024 + h * 128, (const bf16_t*)(ws + WS_KS) + rb * 256 + (h >> 2) * 128,
                                          (const bf16_t*)(ws + WS_PIECES) + rb * NIN + C_SV + (h >> 2) * 128, NT, 4, i0 - 128, i0, sink * 11.313708498984761f, 1.f, (LAS char*)lds, o);
                int ln = lane; asm volatile("" : "+v"(ln));
                const int r32 = ln & 31, hi5 = ln >> 5;
                bf16_t* OBb = (bf16_t*)(ws + WS_OB) + (rb + q0 + wid * 32) * DM + 2048 + h * 128;
                const unsigned lo2 = (unsigned)(4 * hi5 * DM + r32);
#pragma unroll
                for (int r = 0; r < 16; ++r) { bf16_t* q = OBb + ((r & 3) + 8 * (r >> 2)) * DM + lo2;
#pragma unroll
                    for (int d = 0; d < 4; ++d) q[d * 32] = (bf16_t)(cvt_pk_bf16(o[d][r], 0.f) & 0xffffu);
                    asm volatile("" ::: "memory"); }
            }
        } SEAM(mb + 4);
        if (SITE(9) && IN(mb + 5)) REPS(9) {
            pg8::Gemm g = pg8::mk_gemm(OB_, (const bf16_t*)(WL_ + WL_WB), DM, DM, DM, 0, 0); pg8::Order S; S.init_tok(DM / 256, G, bx, DM / 64, 1, (l == DEPTH - 1) ? 1 : 0);
            pg8::EpiMergeH E{SIG_, MG_};
            pg8::gemm_phase<pg8::EpiMergeH, true, true>(lds, g, S, E);
        } SEAM(mb + 5);
        if (SITE(10) && IN(mb + 6)) REPS(10) {
            const bool dummy_ = (REP_SITE == 10) && rep_ == 0;
            pg8::Gemm g = pg8::mk_gemm(MG_, (const bf16_t*)(WL_ + WL_WO), DM, DM, DM, DM / 8, DM / 8); pg8::Order S; S.init_tok(DM / 256, G, bx, DM / 64, 8, (l == DEPTH - 1) ? 1 : 0);
            pg8::EpiResid<false> E{dummy_ ? (float*)(ws + WS_PIECES) : XS_, MODL_ + (size_t)5 * DM, args.out, 0, dummy_ ? (float*)(ws + WS_SIG) : (float*)(ws + WS_PART)};
            pg8::gemm_phase<pg8::EpiResid<false>, true, true>(lds, g, S, E);
        } SEAM(mb + 6);
    }
#undef IN
#undef SEAM
}

#ifndef DBG_NRUN
#define DBG_NRUN 0
#endif
struct DbgSeg { size_t off, n; int bf16; };
#ifndef DBG_SEGS
#define DBG_SEGS {WS_SIG, (size_t)T * 16384, 1}
#endif
__global__ void dbg_dump(const unsigned char* ws, float* out, size_t nout) {
    const DbgSeg segs[] = {DBG_SEGS}; constexpr int NS = sizeof(segs) / sizeof(segs[0]);
    for (size_t i = (size_t)blockIdx.x * blockDim.x + threadIdx.x; i < nout; i += (size_t)gridDim.x * blockDim.x) {
        size_t j = i; int k = 0;
#pragma unroll
        for (int q = 0; q < NS - 1; ++q) if (k == q && j >= segs[q].n) { j -= segs[q].n; k = q + 1; }
        j = j % segs[k].n;
        float v = 0.f;
#pragma unroll
        for (int q = 0; q < NS; ++q) if (k == q) v = segs[q].bf16 ? __uint_as_float((unsigned)((const bf16_t*)(ws + segs[q].off))[j] << 16) : ((const float*)(ws + segs[q].off))[j];
        out[i] = v;
    }
}
extern "C" void kernel_launch(void* const* d_in, const int* in_sizes, int n_in, void* d_out, int out_size, void* d_ws, size_t ws_size, hipStream_t stream) {
    static int grid = 0;
    if (grid == 0) {
        if (n_in != 22 || out_size != NBATCH * SEQ * DM || ws_size < WS_END) { fprintf(stderr, "kernel_launch: unexpected shapes: n_in %d out %d ws %zu (need %zu)\n", n_in, out_size, ws_size, (size_t)WS_END); grid = -1; return; }
        int dev = 0, cus = 0, per_cu = 0;
        if (hipGetDevice(&dev) != hipSuccess || hipDeviceGetAttribute(&cus, hipDeviceAttributeMultiprocessorCount, dev) != hipSuccess) { grid = -1; return; }
        if (hipFuncSetAttribute((const void*)fwd_kernel, hipFuncAttributeMaxDynamicSharedMemorySize, LDS_BYTES) != hipSuccess) { fprintf(stderr, "kernel_launch: hipFuncSetAttribute failed\n"); grid = -1; return; }
        if (hipOccupancyMaxActiveBlocksPerMultiprocessor(&per_cu, (const void*)fwd_kernel, NTHREADS, LDS_BYTES) != hipSuccess || per_cu < 1) { fprintf(stderr, "kernel_launch: occupancy query says %d\n", per_cu); }
        (void)hipGetLastError();
        grid = cus;
    }
    if (grid < 0) return;
    (void)hipMemsetAsync((char*)d_ws + WS_CTL, 0, CTL_ZERO_BYTES, stream);
    Args a{};
    for (int i = 0; i < 22; ++i) a.in[i] = (const float*)d_in[i];
    a.out = (float*)d_out; a.ws = (unsigned char*)d_ws;
#if DBG_NRUN > 0
    for (int p = 0; p < DBG_NRUN; ++p) { a.ph_lo = p; a.ph_hi = p + 1; hipLaunchKernelGGL(fwd_kernel, dim3(grid), dim3(NTHREADS), LDS_BYTES, stream, a); }
    hipLaunchKernelGGL(dbg_dump, dim3(2048), dim3(256), 0, stream, (const unsigned char*)d_ws, (float*)d_out, (size_t)out_size);
#elif MK_PER_PHASE
    for (int p = 0; p < N_PHASES; ++p) { a.ph_lo = p; a.ph_hi = p + 1; hipLaunchKernelGGL(fwd_kernel, dim3(grid), dim3(NTHREADS), LDS_BYTES, stream, a); }
#else
    a.ph_lo = 0; a.ph_hi = N_PHASES;
    hipLaunchKernelGGL(fwd_kernel, dim3(grid), dim3(NTHREADS), LDS_BYTES, stream, a);
#endif
    const hipError_t le = hipPeekAtLastError();
    if (le != hipSuccess) fprintf(stderr, "kernel_launch: launch failed: %s\n", hipGetErrorName(le));
}
```
